# Optimizing an MI355X kernel written in HIP

```python
import math
import jax, jax.numpy as jnp
from jax import lax
import numpy as np

D_MODEL = 1024
BATCH = 4
SEQ = 4096
DEPTH = 2

N_MEM = 256
CONV_WIDTH_CH = D_MODEL // 2
CONV_K = 3
HEAD_DIM = 64
N_Q_HEADS = (D_MODEL // 2) // HEAD_DIM
N_KV_HEADS = 2
GROUP = N_Q_HEADS // N_KV_HEADS
ATTN_WIDTH = N_Q_HEADS * HEAD_DIM
KV_WIDTH = N_KV_HEADS * HEAD_DIM
WINDOW = 128
BLOCK = WINDOW
ROPE_THETA = 10000.0
N_X_HEADS = 4
X_HEAD_DIM = D_MODEL // N_X_HEADS
D_FF = 4 * D_MODEL
EPS = 1e-6
IN_COLS = 3 * CONV_WIDTH_CH + ATTN_WIDTH + 2 * KV_WIDTH

kernel_name = "hybrid_conv_swa_sink_xattn_block"


def rmsnorm(x, g):
    xf = x.astype(jnp.float32)
    y = xf * lax.rsqrt(jnp.mean(xf * xf, axis=-1, keepdims=True) + EPS)
    return (y * g.astype(jnp.float32)).astype(x.dtype)


def rotary_tables(positions, dtype):
    inv_freq = ROPE_THETA ** (-jnp.arange(0, HEAD_DIM, 2, dtype=jnp.float32) / HEAD_DIM)
    ang = positions.astype(jnp.float32)[..., None] * inv_freq
    return jnp.cos(ang)[:, :, None, :].astype(dtype), jnp.sin(ang)[:, :, None, :].astype(dtype)


def apply_rotary(t, cos, sin):
    t1, t2 = jnp.split(t, 2, axis=-1)
    return jnp.concatenate([t1 * cos - t2 * sin, t2 * cos + t1 * sin], axis=-1)


def causal_short_conv(u, w):
    s = u.shape[1]
    up = jnp.pad(u, ((0, 0), (CONV_K - 1, 0), (0, 0)))
    return sum(w[k] * up[:, k:k + s] for k in range(CONV_K))


def sliding_window_attention(q, k, v, sinks):
    b, s = q.shape[0], q.shape[1]
    nb = s // BLOCK
    qb = q.reshape(b, nb, BLOCK, N_KV_HEADS, GROUP, HEAD_DIM)
    kb = k.reshape(b, nb, BLOCK, N_KV_HEADS, HEAD_DIM)
    vb = v.reshape(b, nb, BLOCK, N_KV_HEADS, HEAD_DIM)

    def with_prev(t):
        prev = jnp.pad(t[:, :-1], ((0, 0), (1, 0), (0, 0), (0, 0), (0, 0)))
        return jnp.concatenate([prev, t], axis=2)

    kw, vw = with_prev(kb), with_prev(vb)
    scale = 1.0 / math.sqrt(HEAD_DIM)
    sc = jnp.einsum('bnqhgd,bnkhd->bnhgqk', qb, kw).astype(jnp.float32) * scale
    qi = jnp.arange(BLOCK)[:, None]
    ki = jnp.arange(2 * BLOCK)[None, :]
    diff = BLOCK + qi - ki
    band = (diff >= 0) & (diff < WINDOW)
    blk = jnp.arange(nb)[:, None, None]
    mask = band[None] & ((blk > 0) | (ki >= BLOCK)[None])
    sc = jnp.where(mask[None, :, None, None], sc, -jnp.inf)
    sink = sinks.astype(jnp.float32).reshape(N_KV_HEADS, GROUP)[None, None, :, :, None, None]
    m = jnp.maximum(jnp.max(sc, axis=-1, keepdims=True), sink)
    p = jnp.exp(sc - m)
    denom = jnp.sum(p, axis=-1, keepdims=True) + jnp.exp(sink - m)
    p = (p / denom).astype(v.dtype)
    o = jnp.einsum('bnhgqk,bnkhd->bnqhgd', p, vw)
    return o.reshape(b, s, ATTN_WIDTH)


def memory_cross_attention(h, memn, wq, wkv, wo):
    b, s, _ = h.shape
    q = (h @ wq).reshape(b, s, N_X_HEADS, X_HEAD_DIM)
    kv = memn @ wkv
    k, v = jnp.split(kv, 2, axis=-1)
    k = k.reshape(b, -1, N_X_HEADS, X_HEAD_DIM)
    v = v.reshape(b, -1, N_X_HEADS, X_HEAD_DIM)
    sc = jnp.einsum('bshd,bmhd->bhsm', q, k).astype(jnp.float32) / math.sqrt(X_HEAD_DIM)
    p = jax.nn.softmax(sc, axis=-1).astype(v.dtype)
    o = jnp.einsum('bhsm,bmhd->bshd', p, v).reshape(b, s, D_MODEL)
    return o @ wo


def setup_inputs(seed: int = 0) -> dict:
    key = jax.random.key(seed)
    ks = jax.random.split(key, 20)
    f32 = jnp.float32

    def nrm(k, shape, scale):
        return jax.random.normal(k, shape, f32) * scale

    def gain(k, shape):
        return 1.0 + 0.02 * jax.random.normal(k, shape, f32)

    return {
        "x": jax.random.normal(ks[0], (BATCH, SEQ, D_MODEL), f32),
        "mem": jax.random.normal(ks[1], (BATCH, N_MEM, D_MODEL), f32),
        "positions": jnp.broadcast_to(jnp.arange(SEQ, dtype=jnp.int32), (BATCH, SEQ)),
        "norm_mix_g": gain(ks[2], (DEPTH, D_MODEL)),
        "w_in": nrm(ks[3], (DEPTH, D_MODEL, IN_COLS), D_MODEL ** -0.5),
        "conv_w": nrm(ks[4], (DEPTH, CONV_K, CONV_WIDTH_CH), CONV_K ** -0.5),
        "sinks": nrm(ks[5], (DEPTH, N_Q_HEADS), 0.5),
        "gnorm_conv_g": gain(ks[6], (DEPTH, CONV_WIDTH_CH)),
        "gnorm_attn_g": gain(ks[7], (DEPTH, ATTN_WIDTH)),
        "w_out": nrm(ks[8], (DEPTH, CONV_WIDTH_CH + ATTN_WIDTH, D_MODEL), (CONV_WIDTH_CH + ATTN_WIDTH) ** -0.5),
        "norm_x_g": gain(ks[9], (DEPTH, D_MODEL)),
        "norm_mem_g": gain(ks[10], (DEPTH, D_MODEL)),
        "wx_q": nrm(ks[11], (DEPTH, D_MODEL, D_MODEL), D_MODEL ** -0.5),
        "wx_kv": nrm(ks[12], (DEPTH, D_MODEL, 2 * D_MODEL), D_MODEL ** -0.5),
        "wx_o": nrm(ks[13], (DEPTH, D_MODEL, D_MODEL), D_MODEL ** -0.5),
        "norm_mlp_g": gain(ks[14], (DEPTH, D_MODEL)),
        "w_up": nrm(ks[15], (DEPTH, D_MODEL, D_FF), D_MODEL ** -0.5),
        "w_down": nrm(ks[16], (DEPTH, D_FF, D_MODEL), D_FF ** -0.5),
        "final_g": gain(ks[17], (D_MODEL,)),
    }


def reference(x, mem, positions, norm_mix_g, w_in, conv_w, sinks, gnorm_conv_g,
              gnorm_attn_g, w_out, norm_x_g, norm_mem_g, wx_q, wx_kv, wx_o,
              norm_mlp_g, w_up, w_down, final_g):
    b, s, _ = x.shape
    cos, sin = rotary_tables(positions, x.dtype)
    splits = np.cumsum([CONV_WIDTH_CH, CONV_WIDTH_CH, CONV_WIDTH_CH, ATTN_WIDTH, KV_WIDTH]).tolist()
    for l in range(DEPTH):
        h = rmsnorm(x, norm_mix_g[l])
        u = h @ w_in[l]
        gb, gc, xc, q, k, v = jnp.split(u, splits, axis=-1)
        conv_out = gb * causal_short_conv(gc * xc, conv_w[l])
        q = apply_rotary(q.reshape(b, s, N_Q_HEADS, HEAD_DIM), cos, sin)
        k = apply_rotary(k.reshape(b, s, N_KV_HEADS, HEAD_DIM), cos, sin)
        v = v.reshape(b, s, N_KV_HEADS, HEAD_DIM)
        attn_out = sliding_window_attention(q, k, v, sinks[l])
        mixed = jnp.concatenate([rmsnorm(conv_out, gnorm_conv_g[l]),
                                 rmsnorm(attn_out, gnorm_attn_g[l])], axis=-1)
        x = x + mixed @ w_out[l]
        x = x + memory_cross_attention(rmsnorm(x, norm_x_g[l]), rmsnorm(mem, norm_mem_g[l]),
                                       wx_q[l], wx_kv[l], wx_o[l])
        hm = rmsnorm(x, norm_mlp_g[l])
        x = x + jnp.square(jax.nn.relu(hm @ w_up[l])) @ w_down[l]
    return rmsnorm(x, final_g)
```

```cpp
#include <hip/hip_runtime.h>
#include <hip/hip_cooperative_groups.h>
#include <cstdio>
#include <cstdint>
namespace cg = cooperative_groups;

#ifndef MK_MULTI
#define MK_MULTI 1
#endif

#define DI __device__ __forceinline__
#define LAS __attribute__((address_space(3)))
typedef unsigned short bf16_t;
typedef short bf16x8 __attribute__((ext_vector_type(8)));
typedef short s16x4 __attribute__((ext_vector_type(4)));
typedef float f32x2 __attribute__((ext_vector_type(2)));
typedef float f32x4 __attribute__((ext_vector_type(4)));
typedef float f32x16 __attribute__((ext_vector_type(16)));
typedef unsigned u32x2 __attribute__((ext_vector_type(2)));
typedef unsigned u32x4 __attribute__((ext_vector_type(4)));
typedef __bf16 bf16x2_t __attribute__((ext_vector_type(2)));

constexpr int NB = 4, SEQ = 4096, T = NB * SEQ, D = 1024, NMEM = 256, MROWS = NB * NMEM, INC = 2304, FF = 4096, DEPTH = 2;
constexpr float EPS = 1e-6f, LOG2E = 1.4426950408889634f;
constexpr float QSCALE = 0.125f * LOG2E;
constexpr float XSCALE = 0.0625f * LOG2E;

constexpr size_t MiB = 1u << 20;
constexpr size_t WS_SSQ = 1 * MiB;
constexpr size_t WS_W = 2 * MiB;
constexpr size_t LW_IN = 0, LW_OUT = 9 * MiB / 2, LW_Q = 13 * MiB / 2, LW_KV = 17 * MiB / 2, LW_O = 25 * MiB / 2, LW_UP = 29 * MiB / 2, LW_DN = 45 * MiB / 2, LW_STRIDE = 61 * MiB / 2;
constexpr size_t WS_XB = 64 * MiB;
constexpr size_t WS_U = 96 * MiB;
constexpr size_t WS_MIX = 168 * MiB;
constexpr size_t WS_QX = 96 * MiB, WS_P = 128 * MiB, WS_OX = 168 * MiB;
constexpr size_t WS_H = 96 * MiB;
constexpr size_t WS_KMEM = 224 * MiB;
constexpr size_t WS_VT = 228 * MiB;
constexpr size_t WS_MEMN = 232 * MiB;
constexpr size_t WS_ROT = 234 * MiB;
constexpr size_t WS_END = 238 * MiB;

constexpr int RING_BYTES = 131072, SCR_OFF = RING_BYTES + 1024, LDS_BYTES = 147456;

DI unsigned pk2(float lo, float hi) { f32x2 v = {lo, hi}; bf16x2_t b = __builtin_convertvector(v, bf16x2_t); return __builtin_bit_cast(unsigned, b); }
DI float bf_lo(unsigned w) { return __uint_as_float(w << 16); }
DI float bf_hi(unsigned w) { return __uint_as_float(w & 0xffff0000u); }
DI float row_rstd(const float* ssq, int row) {
    const f32x4* p = (const f32x4*)(ssq + (size_t)row * 16);
    const f32x4 a = p[0], b = p[1], c = p[2], d = p[3];
    const float s = ((a[0] + a[1]) + (a[2] + a[3])) + ((b[0] + b[1]) + (b[2] + b[3])) + ((c[0] + c[1]) + (c[2] + c[3])) + ((d[0] + d[1]) + (d[2] + d[3]));
    return 1.0f / sqrtf(s * (1.0f / 1024.0f) + EPS);
}

namespace pg8 {
constexpr int BM = 256, BK = 64, HALF = 128, HTB = HALF * BK * 2, NXCD = 8, WGM = 8;
__host__ __device__ __forceinline__ int lds_byte(int r, int c) { const int st = (r >> 4) * 2 + (c >> 5), rr = r & 15, cc = c & 31, ob = rr * 64 + cc * 2; return st * 1024 + (ob ^ (((ob >> 9) & 1) << 5)); }
__host__ __device__ __forceinline__ void stage_rc(int b, int& R, int& C) { const int st = b / 1024, sb = b % 1024, swz = sb ^ (((sb >> 9) & 1) << 5); R = (st >> 1) * 16 + swz / 64; C = (st & 1) * 32 + (swz % 64) / 2; }
__host__ __device__ __forceinline__ int perm32(int rho) { const int n = rho >> 4, i = rho & 15; return 8 * (i >> 2) + 4 * n + (i & 3); }

struct Unit { int pm, pn; };
struct Gemm { const bf16_t* A; const bf16_t* Bt; int K, lda, ldb, nM, nN; long a_pn_off, b_pn_off, b_batch_off; int b_pm_div; };
DI const char* abase(const Gemm& g, const Unit& u) { return (const char*)(g.A + (size_t)u.pm * BM * g.lda + (size_t)u.pn * g.a_pn_off); }
DI const char* bbase(const Gemm& g, const Unit& u) { return (const char*)(g.Bt + (size_t)u.pn * g.b_pn_off + (size_t)(u.pm / g.b_pm_div) * g.b_batch_off); }

struct StaticOrder {
    int nM, nN, nwg, G, c;
    DI void init(int nM_, int nN_, int G_, int c_) { nM = nM_; nN = nN_; nwg = nM * nN; G = G_; c = c_; }
    DI bool next(int i, Unit& u) const {
        const long L = (long)i * G + c; if (L >= nwg) return false;
        int wgid = (int)L; { const int q = nwg / NXCD, r = nwg % NXCD, xcd = wgid % NXCD, off = wgid / NXCD; wgid = (xcd < r ? xcd * (q + 1) : r * (q + 1) + (xcd - r) * q) + off; }
        const int nig = WGM * nN, gid = wgid / nig, fm = gid * WGM, gsz = (nM - fm) < WGM ? (nM - fm) : WGM;
        u.pm = fm + ((wgid % nig) % gsz); u.pn = (wgid % nig) / gsz; return true;
    }
};

typedef f32x4 Acc[2][2][4][2];

template <int ACT> struct EpiScale {
    static constexpr bool PERM = true;
    bf16_t* O; int ldc; const float* ssq; float scale;
    DI void operator()(Acc& acc, const Unit& u, int wr, int wc, int fr, int fq, LAS unsigned char*) const {
        const int row0 = u.pm * BM + wr * 64 + fr, col0 = u.pn * BM + wc * 32 + 8 * fq;
#pragma unroll
        for (int ai = 0; ai < 2; ++ai)
#pragma unroll
            for (int m = 0; m < 4; ++m) {
                const int row = row0 + ai * HALF + m * 16;
                const float rs = ssq ? row_rstd(ssq, row) * scale : scale;
                bf16_t* rowp = O + (size_t)row * ldc + col0;
#pragma unroll
                for (int bj = 0; bj < 2; ++bj) {
                    f32x4 v0 = acc[ai][bj][m][0] * rs, v1 = acc[ai][bj][m][1] * rs;
                    if (ACT == 1) {
#pragma unroll
                        for (int e = 0; e < 4; ++e) { const float a = fmaxf(v0[e], 0.f), b = fmaxf(v1[e], 0.f); v0[e] = a * a; v1[e] = b * b; }
                    }
                    u32x4 w; w.x = pk2(v0[0], v0[1]); w.y = pk2(v0[2], v0[3]); w.z = pk2(v1[0], v1[1]); w.w = pk2(v1[2], v1[3]);
                    *(u32x4*)(rowp + bj * HALF) = w;
                }
            }
    }
};

struct EpiWin {
    static constexpr bool PERM = true;
    bf16_t* U; const float* ssq; const float* rot;
    DI void operator()(Acc& acc, const Unit& u, int wr, int wc, int fr, int fq, LAS unsigned char*) const {
        const int row0 = u.pm * BM + wr * 64 + fr, col0 = u.pn * BM + wc * 32 + 8 * fq;
        const bool isq = (u.pn == 6) || (u.pn == 7), isk8 = (u.pn == 8);
        const int i0 = 16 * (wc & 1) + 4 * fq;
#pragma unroll
        for (int ai = 0; ai < 2; ++ai)
#pragma unroll
            for (int m = 0; m < 4; ++m) {
                const int row = row0 + ai * HALF + m * 16;
                const float rs = row_rstd(ssq, row);
                bf16_t* rowp = U + (size_t)row * INC + col0;
                f32x4 cs0 = {1.f, 0.f, 1.f, 0.f}, cs1 = {1.f, 0.f, 1.f, 0.f};
                if (isq || isk8) { const f32x4* rp = (const f32x4*)(rot + ((size_t)row * 32 + i0) * 2); cs0 = rp[0]; cs1 = rp[1]; }
#pragma unroll
                for (int bj = 0; bj < 2; ++bj) {
                    f32x4 v0 = acc[ai][bj][m][0] * rs, v1 = acc[ai][bj][m][1] * rs;
                    if (isq || (isk8 && bj == 0)) {
                        const float sc = isq ? QSCALE : 1.0f;
                        f32x4 r0, r1;
                        r0[0] = (v0[0] * cs0[0] - v0[1] * cs0[1]) * sc; r0[1] = (v0[1] * cs0[0] + v0[0] * cs0[1]) * sc;
                        r0[2] = (v0[2] * cs0[2] - v0[3] * cs0[3]) * sc; r0[3] = (v0[3] * cs0[2] + v0[2] * cs0[3]) * sc;
                        r1[0] = (v1[0] * cs1[0] - v1[1] * cs1[1]) * sc; r1[1] = (v1[1] * cs1[0] + v1[0] * cs1[1]) * sc;
                        r1[2] = (v1[2] * cs1[2] - v1[3] * cs1[3]) * sc; r1[3] = (v1[3] * cs1[2] + v1[2] * cs1[3]) * sc;
                        v0 = r0; v1 = r1;
                    }
                    u32x4 w; w.x = pk2(v0[0], v0[1]); w.y = pk2(v0[2], v0[3]); w.z = pk2(v1[0], v1[1]); w.w = pk2(v1[2], v1[3]);
                    *(u32x4*)(rowp + bj * HALF) = w;
                }
            }
    }
};

struct EpiResid {
    static constexpr bool PERM = false;
    const float* base; float* out; bf16_t* xb; float* ssq;
    DI void operator()(Acc& acc, const Unit& u, int wr, int wc, int fr, int fq, LAS unsigned char*) const {
        const int row0 = u.pm * BM + wr * 64 + fr, col0 = u.pn * BM + wc * 32 + 4 * fq;
#pragma unroll
        for (int ai = 0; ai < 2; ++ai)
#pragma unroll
            for (int m = 0; m < 4; ++m) {
                const int row = row0 + ai * HALF + m * 16; const size_t off = (size_t)row * D + col0;
                float s = 0.f;
#pragma unroll
                for (int bj = 0; bj < 2; ++bj)
#pragma unroll
                    for (int n = 0; n < 2; ++n) {
                        const f32x4 bs = *(const f32x4*)(base + off + bj * HALF + n * 16);
                        const f32x4 o = bs + acc[ai][bj][m][n];
                        *(f32x4*)(out + off + bj * HALF + n * 16) = o;
                        u32x2 w; w.x = pk2(o[0], o[1]); w.y = pk2(o[2], o[3]);
                        *(u32x2*)(xb + off + bj * HALF + n * 16) = w;
                        s += (o[0] * o[0] + o[1] * o[1]) + (o[2] * o[2] + o[3] * o[3]);
                    }
                s += __shfl_xor(s, 16); s += __shfl_xor(s, 32);
                if (fq == 0) ssq[(size_t)row * 16 + u.pn * 4 + wc] = s;
            }
    }
};

struct EpiSoftmax {
    static constexpr bool PERM = true;
    bf16_t* P; int ldc;
    DI void operator()(Acc& acc, const Unit& u, int wr, int wc, int fr, int fq, LAS unsigned char* scr) const {
        LAS f32x2* X = (LAS f32x2*)scr;
        float mw[2][4];
#pragma unroll
        for (int ai = 0; ai < 2; ++ai)
#pragma unroll
            for (int m = 0; m < 4; ++m) {
                float mx = -INFINITY;
#pragma unroll
                for (int bj = 0; bj < 2; ++bj)
#pragma unroll
                    for (int n = 0; n < 2; ++n)
#pragma unroll
                        for (int e = 0; e < 4; ++e) mx = fmaxf(mx, acc[ai][bj][m][n][e]);
                mx = fmaxf(mx, __shfl_xor(mx, 16)); mx = fmaxf(mx, __shfl_xor(mx, 32));
                float s = 0.f;
#pragma unroll
                for (int bj = 0; bj < 2; ++bj)
#pragma unroll
                    for (int n = 0; n < 2; ++n)
#pragma unroll
                        for (int e = 0; e < 4; ++e) { const float p = __builtin_amdgcn_exp2f(acc[ai][bj][m][n][e] - mx); acc[ai][bj][m][n][e] = p; s += p; }
                s += __shfl_xor(s, 16); s += __shfl_xor(s, 32);
                mw[ai][m] = mx;
                if (fq == 0) X[(ai * HALF + wr * 64 + m * 16 + fr) * 4 + wc] = (f32x2){mx, s};
            }
        asm volatile("s_waitcnt lgkmcnt(0)" ::: "memory"); __builtin_amdgcn_s_barrier(); asm volatile("" ::: "memory");
        const int row0 = u.pm * BM + wr * 64 + fr, col0 = u.pn * BM + wc * 32 + 8 * fq;
#pragma unroll
        for (int ai = 0; ai < 2; ++ai)
#pragma unroll
            for (int m = 0; m < 4; ++m) {
                const int rl = ai * HALF + wr * 64 + m * 16 + fr;
                const f32x2 a = X[rl * 4 + 0], b = X[rl * 4 + 1], c = X[rl * 4 + 2], d = X[rl * 4 + 3];
                const float M = fmaxf(fmaxf(a.x, b.x), fmaxf(c.x, d.x));
                const float tot = a.y * __builtin_amdgcn_exp2f(a.x - M) + b.y * __builtin_amdgcn_exp2f(b.x - M) + c.y * __builtin_amdgcn_exp2f(c.x - M) + d.y * __builtin_amdgcn_exp2f(d.x - M);
                const float sc = __builtin_amdgcn_exp2f(mw[ai][m] - M) / tot;
                bf16_t* rowp = P + (size_t)(row0 + ai * HALF + m * 16) * ldc + col0;
#pragma unroll
                for (int bj = 0; bj < 2; ++bj) {
                    const f32x4 v0 = acc[ai][bj][m][0] * sc, v1 = acc[ai][bj][m][1] * sc;
                    u32x4 w; w.x = pk2(v0[0], v0[1]); w.y = pk2(v0[2], v0[3]); w.z = pk2(v1[0], v1[1]); w.w = pk2(v1[2], v1[3]);
                    *(u32x4*)(rowp + bj * HALF) = w;
                }
            }
        asm volatile("s_waitcnt lgkmcnt(0)" ::: "memory"); __builtin_amdgcn_s_barrier(); asm volatile("" ::: "memory");
    }
};

template <class Epi>
DI void gemm_phase(LAS unsigned char* lds, LAS unsigned char* scr, const Gemm g, const StaticOrder& S, const Epi& E) {
    int tid = threadIdx.x; asm volatile("" : "+v"(tid));
    const int wid = __builtin_amdgcn_readfirstlane(tid >> 6), lane = tid & 63, wr = wid >> 2, wc = wid & 3, fr = lane & 15, fq = lane >> 4;
    const int nt = g.K / BK;
    unsigned voffA[2], voffB[2];
#pragma unroll
    for (int i = 0; i < 2; ++i) { int R, C; stage_rc(tid * 16 + i * 8192, R, C); const int Rb = Epi::PERM ? ((R & ~31) + perm32(R & 31)) : R;
        voffA[i] = (unsigned)(R * g.lda + C) * 2u; voffB[i] = (unsigned)(Rb * g.ldb + C) * 2u; }
    const size_t kstep = (size_t)(BK * 2);
    const size_t hsA = (size_t)HALF * g.lda * 2, hsB = (size_t)HALF * g.ldb * 2;
    const unsigned ldsw = (unsigned)wid * 1024u;
    const int aoff = lds_byte(wr * 64 + fr, fq * 8), boff = lds_byte(wc * 32 + fr, fq * 8);
#define PG8_SA(b, h) (((b) * 2 + (h)) * HTB)
#define PG8_SB(b, h) ((4 + (b) * 2 + (h)) * HTB)
#define PG8_STAGE(bufoff, gbase, voff) do { _Pragma("unroll") for (int _i = 0; _i < 2; ++_i) \
        __builtin_amdgcn_global_load_lds((const unsigned*)((const char*)(gbase) + (voff)[_i]), (LAS unsigned*)(lds + (bufoff) + ldsw + _i * 8192), 16, 0, 0); } while (0)
#define PG8_LDA(dst, b, h) do { _Pragma("unroll") for (int m = 0; m < 4; ++m) _Pragma("unroll") for (int k = 0; k < 2; ++k) dst[m][k] = *(const LAS bf16x8*)(lds + PG8_SA(b, h) + aoff + m * 2048 + k * 1024); } while (0)
#define PG8_LDB(dst, b, h) do { _Pragma("unroll") for (int n = 0; n < 2; ++n) _Pragma("unroll") for (int k = 0; k < 2; ++k) dst[n][k] = *(const LAS bf16x8*)(lds + PG8_SB(b, h) + boff + n * 2048 + k * 1024); } while (0)
#define PG8_MMA(ai, bj, At, Bt) do { __builtin_amdgcn_s_setprio(1); _Pragma("unroll") for (int m = 0; m < 4; ++m) _Pragma("unroll") for (int n = 0; n < 2; ++n) _Pragma("unroll") for (int k = 0; k < 2; ++k) \
        acc[ai][bj][m][n] = __builtin_amdgcn_mfma_f32_16x16x32_bf16(Bt[n][k], At[m][k], acc[ai][bj][m][n], 0, 0, 0); __builtin_amdgcn_s_setprio(0); } while (0)
#define PG8_WAIT_V(n) asm volatile("s_waitcnt vmcnt(" #n ")" ::: "memory")
#define PG8_WAIT_L(n) asm volatile("s_waitcnt lgkmcnt(" #n ")" ::: "memory")
#define PG8_BAR __builtin_amdgcn_s_barrier()
#define PG8_SCHED __builtin_amdgcn_sched_barrier(0)
    Unit cur, nxt; int ui = 0;
    if (!S.next(0, cur)) return;
    Acc acc;
#pragma unroll
    for (int a = 0; a < 2; ++a)
#pragma unroll
        for (int b = 0; b < 2; ++b)
#pragma unroll
            for (int m = 0; m < 4; ++m)
#pragma unroll
                for (int n = 0; n < 2; ++n) acc[a][b][m][n] = (f32x4){0.f, 0.f, 0.f, 0.f};
    bf16x8 At[4][2], B0[2][2], B1[2][2];
    const char* cA = abase(g, cur); const char* cB = bbase(g, cur);
    PG8_STAGE(PG8_SB(0, 0), cB, voffB); PG8_STAGE(PG8_SB(0, 1), cB + hsB, voffB); PG8_STAGE(PG8_SA(0, 0), cA, voffA); PG8_STAGE(PG8_SA(0, 1), cA + hsA, voffA);
    if (wr == 1) PG8_BAR;
    PG8_WAIT_V(2); PG8_BAR;
    PG8_STAGE(PG8_SB(1, 0), cB + kstep, voffB); PG8_STAGE(PG8_SA(1, 0), cA + kstep, voffA); PG8_STAGE(PG8_SB(1, 1), cB + hsB + kstep, voffB);
    PG8_WAIT_V(6); PG8_BAR;
    for (;;) {
        const bool has_next = S.next(ui + 1, nxt);
        const char* nA = has_next ? abase(g, nxt) : cA; const char* nB = has_next ? bbase(g, nxt) : cB;
        for (int t = 0; t < nt; t += 2) {
            const bool last = (t == nt - 2);
            const char* a1 = cA + (size_t)(t + 1) * kstep;
            const char* a2 = last ? nA : cA + (size_t)(t + 2) * kstep; const char* b2 = last ? nB : cB + (size_t)(t + 2) * kstep;
            const char* a3 = a2 + kstep; const char* b3 = b2 + kstep;
            PG8_LDB(B0, 0, 0); PG8_LDB(B1, 0, 1); PG8_SCHED; PG8_LDA(At, 0, 0); PG8_STAGE(PG8_SA(1, 1), a1 + hsA, voffA);
            PG8_WAIT_V(8); PG8_WAIT_L(0); PG8_BAR; PG8_MMA(0, 0, At, B0); PG8_MMA(0, 1, At, B1); PG8_BAR; PG8_SCHED;
            PG8_LDA(At, 0, 1); PG8_STAGE(PG8_SB(0, 0), b2, voffB); PG8_STAGE(PG8_SB(0, 1), b2 + hsB, voffB); PG8_STAGE(PG8_SA(0, 0), a2, voffA);
            PG8_WAIT_V(8); PG8_WAIT_L(0); PG8_BAR; PG8_MMA(1, 0, At, B0); PG8_MMA(1, 1, At, B1); PG8_BAR; PG8_SCHED;
            PG8_LDB(B0, 1, 0); PG8_LDB(B1, 1, 1); PG8_SCHED; PG8_LDA(At, 1, 0); PG8_STAGE(PG8_SA(0, 1), a2 + hsA, voffA);
            PG8_WAIT_V(8); PG8_WAIT_L(0); PG8_BAR; PG8_MMA(0, 0, At, B0); PG8_MMA(0, 1, At, B1); PG8_BAR; PG8_SCHED;
            PG8_LDA(At, 1, 1); PG8_STAGE(PG8_SB(1, 0), b3, voffB); PG8_STAGE(PG8_SB(1, 1), b3 + hsB, voffB); PG8_STAGE(PG8_SA(1, 0), a3, voffA);
            PG8_WAIT_V(8); PG8_WAIT_L(0); PG8_BAR; PG8_MMA(1, 0, At, B0); PG8_MMA(1, 1, At, B1); PG8_BAR; PG8_SCHED;
        }
        if (wr == 0) PG8_BAR;
        E(acc, cur, wr, wc, fr, fq, scr);
        if (!has_next) break;
#pragma unroll
        for (int a = 0; a < 2; ++a)
#pragma unroll
            for (int b = 0; b < 2; ++b)
#pragma unroll
                for (int m = 0; m < 4; ++m)
#pragma unroll
                    for (int n = 0; n < 2; ++n) acc[a][b][m][n] = (f32x4){0.f, 0.f, 0.f, 0.f};
        cur = nxt; cA = nA; cB = nB; ++ui;
        if (wr == 1) PG8_BAR;
    }
    PG8_WAIT_V(0);
    PG8_BAR;
#undef PG8_SA
#undef PG8_SB
#undef PG8_STAGE
#undef PG8_LDA
#undef PG8_LDB
#undef PG8_MMA
#undef PG8_WAIT_V
#undef PG8_WAIT_L
#undef PG8_BAR
#undef PG8_SCHED
}
}

DI float wave_sum(float v) {
#pragma unroll
    for (int o = 1; o < 64; o <<= 1) v += __shfl_xor(v, o);
    return v;
}
DI void p0_transpose_item(const float* W, int K, int N, bf16_t* WT, const float* g, const float* g2, int rot_lo, int rot_hi, LAS float* scr, int item, int lane) {
    const int nblk = N / 32, kb = item / nblk, nb = item % nblk, k0 = 64 * kb, n0 = 32 * nb;
    int nsrc = n0 + (lane & 31);
    if (nsrc >= rot_lo && nsrc < rot_hi) { const int dd = nsrc & 63; nsrc = (nsrc & ~63) + (dd & 1) * 32 + (dd >> 1); }
#pragma unroll 8
    for (int i = 0; i < 32; ++i) {
        const int kk = 2 * i + (lane >> 5), k = k0 + kk;
        float gv = 1.0f;
        if (g) gv = (g2 && k >= 512) ? g2[k - 512] : g[k];
        scr[kk * 33 + (lane & 31)] = W[(size_t)k * N + nsrc] * gv;
    }
    asm volatile("s_waitcnt lgkmcnt(0)" ::: "memory");
    const int c = lane & 7;
#pragma unroll
    for (int j = 0; j < 4; ++j) { const int n = (lane >> 3) + 8 * j; const LAS float* s = scr + (8 * c) * 33 + n;
        u32x4 o; o.x = pk2(s[0 * 33], s[1 * 33]); o.y = pk2(s[2 * 33], s[3 * 33]); o.z = pk2(s[4 * 33], s[5 * 33]); o.w = pk2(s[6 * 33], s[7 * 33]);
        *(u32x4*)(WT + (size_t)(n0 + n) * K + k0 + 8 * c) = o; }
    asm volatile("s_waitcnt lgkmcnt(0)" ::: "memory");
}

constexpr int SW_KOFF = 0, SW_KSTR = 272, SW_VOFF = 192 * 272, SW_VSTR = 320, SW_XOFF = SW_VOFF + 192 * 320;
static_assert(SW_XOFF + 2 * 32 * 8 * 4 <= RING_BYTES, "swa LDS");
DI int crow(int r, int hi) { return (r & 3) + 8 * (r >> 2) + 4 * hi; }
typedef short v4i16_t __attribute__((ext_vector_type(4)));
DI s16x4 vtr(LAS unsigned char* p) { return __builtin_bit_cast(s16x4, __builtin_amdgcn_ds_read_tr16_b64_v4i16((LAS v4i16_t*)p)); }

DI void swa_conv_unit(int unit, const bf16_t* U, bf16_t* MIX, const float* convw, const float* sinks, LAS unsigned char* lds) {
    int tid = threadIdx.x; asm volatile("" : "+v"(tid));
    const int lane = tid & 63, wid = __builtin_amdgcn_readfirstlane(tid >> 6);
    const int b = unit >> 6, qt = unit & 63, q0s = qt * 64, tok0 = b * SEQ + q0s;
#pragma unroll
    for (int it = 0; it < 6; ++it) {
        const int id = it * 512 + tid, key = id >> 4, ch = id & 15;
        u32x4 kv = {0u, 0u, 0u, 0u}, vv = {0u, 0u, 0u, 0u};
        if (q0s - 128 + key >= 0) { const bf16_t* rowp = U + (size_t)(tok0 - 128 + key) * INC; kv = *(const u32x4*)(rowp + 2048 + ch * 8); vv = *(const u32x4*)(rowp + 2176 + ch * 8); }
        *(LAS u32x4*)(lds + SW_KOFF + key * SW_KSTR + ch * 16) = kv;
        *(LAS u32x4*)(lds + SW_VOFF + key * SW_VSTR + ch * 16) = vv;
    }
    {
        const int c0 = lane * 8, t0 = tok0 + 8 * wid, s0 = q0s + 8 * wid;
        float w0[8], w1[8], w2[8], p2[8], p1[8];
#pragma unroll
        for (int e = 0; e < 8; ++e) { w0[e] = convw[c0 + e]; w1[e] = convw[512 + c0 + e]; w2[e] = convw[1024 + c0 + e]; p2[e] = 0.f; p1[e] = 0.f; }
        if (s0 >= 2) {
            const bf16_t* r2 = U + (size_t)(t0 - 2) * INC; const bf16_t* r1 = U + (size_t)(t0 - 1) * INC;
            const u32x4 gc2 = *(const u32x4*)(r2 + 512 + c0), xc2 = *(const u32x4*)(r2 + 1024 + c0), gc1 = *(const u32x4*)(r1 + 512 + c0), xc1 = *(const u32x4*)(r1 + 1024 + c0);
#pragma unroll
            for (int e = 0; e < 4; ++e) { p2[2 * e] = bf_lo(gc2[e]) * bf_lo(xc2[e]); p2[2 * e + 1] = bf_hi(gc2[e]) * bf_hi(xc2[e]); p1[2 * e] = bf_lo(gc1[e]) * bf_lo(xc1[e]); p1[2 * e + 1] = bf_hi(gc1[e]) * bf_hi(xc1[e]); }
        }
#pragma unroll 2
        for (int j = 0; j < 8; ++j) {
            const bf16_t* r = U + (size_t)(t0 + j) * INC;
            const u32x4 gb = *(const u32x4*)(r + c0), gc = *(const u32x4*)(r + 512 + c0), xc = *(const u32x4*)(r + 1024 + c0);
            float pc[8], o[8]; float ss = 0.f;
#pragma unroll
            for (int e = 0; e < 4; ++e) { pc[2 * e] = bf_lo(gc[e]) * bf_lo(xc[e]); pc[2 * e + 1] = bf_hi(gc[e]) * bf_hi(xc[e]); }
#pragma unroll
            for (int e = 0; e < 8; ++e) {
                const float cv = w0[e] * p2[e] + w1[e] * p1[e] + w2[e] * pc[e];
                const float gbv = (e & 1) ? bf_hi(gb[e >> 1]) : bf_lo(gb[e >> 1]);
                o[e] = gbv * cv; ss += o[e] * o[e];
            }
            ss = wave_sum(ss);
            const float rs = 1.0f / sqrtf(ss * (1.0f / 512.0f) + EPS);
            u32x4 w; w.x = pk2(o[0] * rs, o[1] * rs); w.y = pk2(o[2] * rs, o[3] * rs); w.z = pk2(o[4] * rs, o[5] * rs); w.w = pk2(o[6] * rs, o[7] * rs);
            *(u32x4*)(MIX + (size_t)(t0 + j) * D + c0) = w;
#pragma unroll
            for (int e = 0; e < 8; ++e) { p2[e] = p1[e]; p1[e] = pc[e]; }
        }
    }
    const int h = wid, kvh = h >> 2, r32 = lane & 31, hi = lane >> 5;
    const float sink2 = sinks[h] * LOG2E;
    __syncthreads();
    LAS float* X = (LAS float*)(lds + SW_XOFF);
    const int qq = (lane & 15) >> 2, pp = lane & 3, gg = (lane >> 4) & 1;
#pragma unroll 1
    for (int qs = 0; qs < 2; ++qs) {
        bf16x8 qf[4];
#pragma unroll
        for (int kb = 0; kb < 4; ++kb) qf[kb] = *(const bf16x8*)(U + (size_t)(tok0 + 32 * qs + r32) * INC + 1536 + h * 64 + 16 * kb + 8 * hi);
        f32x16 st[5];
#pragma unroll
        for (int kt = 0; kt < 5; ++kt) {
#pragma unroll
            for (int r = 0; r < 16; ++r) st[kt][r] = 0.f;
#pragma unroll
            for (int kb = 0; kb < 4; ++kb) {
                const bf16x8 kf = *(const LAS bf16x8*)(lds + SW_KOFF + (32 * (qs + kt) + r32) * SW_KSTR + (kvh * 64 + 16 * kb + 8 * hi) * 2);
                st[kt] = __builtin_amdgcn_mfma_f32_32x32x16_bf16(kf, qf[kb], st[kt], 0, 0, 0);
            }
        }
        float mx = sink2;
        const int kpos0 = q0s + 32 * qs - 128;
#pragma unroll
        for (int kt = 0; kt < 5; ++kt)
#pragma unroll
            for (int r = 0; r < 16; ++r) {
                const int kr = 32 * kt + crow(r, hi);
                const bool valid = (kr > r32) && (kr <= r32 + 128) && (kpos0 + kr >= 0);
                const float v = valid ? st[kt][r] : -INFINITY;
                st[kt][r] = v; mx = fmaxf(mx, v);
            }
        mx = fmaxf(mx, __shfl_xor(mx, 32));
        float sum = 0.f;
#pragma unroll
        for (int kt = 0; kt < 5; ++kt)
#pragma unroll
            for (int r = 0; r < 16; ++r) { const float p = __builtin_amdgcn_exp2f(st[kt][r] - mx); st[kt][r] = p; sum += p; }
        sum += __shfl_xor(sum, 32);
        sum += __builtin_amdgcn_exp2f(sink2 - mx);
        const float inv = 1.0f / sum;
        f32x16 o[2];
#pragma unroll
        for (int r = 0; r < 16; ++r) { o[0][r] = 0.f; o[1][r] = 0.f; }
#pragma unroll
        for (int kt = 0; kt < 5; ++kt)
#pragma unroll
            for (int s = 0; s < 2; ++s) {
                u32x4 pw; pw.x = pk2(st[kt][8 * s + 0], st[kt][8 * s + 1]); pw.y = pk2(st[kt][8 * s + 2], st[kt][8 * s + 3]); pw.z = pk2(st[kt][8 * s + 4], st[kt][8 * s + 5]); pw.w = pk2(st[kt][8 * s + 6], st[kt][8 * s + 7]);
                const bf16x8 pf = __builtin_bit_cast(bf16x8, pw);
#pragma unroll
                for (int dt = 0; dt < 2; ++dt) {
                    LAS unsigned char* vb = lds + SW_VOFF + (32 * (qs + kt) + 16 * s + 4 * hi + qq) * SW_VSTR + (kvh * 64 + 32 * dt + 16 * gg) * 2 + 8 * pp;
                    const s16x4 lo = vtr(vb), hi4 = vtr(vb + 8 * SW_VSTR);
                    const bf16x8 vf = __builtin_shufflevector(lo, hi4, 0, 1, 2, 3, 4, 5, 6, 7);
                    o[dt] = __builtin_amdgcn_mfma_f32_32x32x16_bf16(vf, pf, o[dt], 0, 0, 0);
                }
            }
        float ss = 0.f;
#pragma unroll
        for (int dt = 0; dt < 2; ++dt)
#pragma unroll
            for (int r = 0; r < 16; ++r) { o[dt][r] *= inv; ss += o[dt][r] * o[dt][r]; }
        ss += __shfl_xor(ss, 32);
        if (hi == 0) X[(qs * 32 + r32) * 8 + h] = ss;
        __syncthreads();
        const f32x4 xa = *(const LAS f32x4*)(X + (qs * 32 + r32) * 8), xb4 = *(const LAS f32x4*)(X + (qs * 32 + r32) * 8 + 4);
        const float tot = ((xa[0] + xa[1]) + (xa[2] + xa[3])) + ((xb4[0] + xb4[1]) + (xb4[2] + xb4[3]));
        const float rs = 1.0f / sqrtf(tot * (1.0f / 512.0f) + EPS);
        bf16_t* orow = MIX + (size_t)(tok0 + 32 * qs + r32) * D + 512 + h * 64 + 4 * hi;
#pragma unroll
        for (int dt = 0; dt < 2; ++dt)
#pragma unroll
            for (int g4 = 0; g4 < 4; ++g4) {
                u32x2 w; w.x = pk2(o[dt][4 * g4 + 0] * rs, o[dt][4 * g4 + 1] * rs); w.y = pk2(o[dt][4 * g4 + 2] * rs, o[dt][4 * g4 + 3] * rs);
                *(u32x2*)(orow + 32 * dt + 8 * g4) = w;
            }
    }
    __syncthreads();
}

struct Args { const void* in[19]; float* out; unsigned char* ws; int ph_lo, ph_hi; };
constexpr int N_PHASES = 20;

__global__ void __launch_bounds__(512, 2) mk_fwd(Args args) {
    extern __shared__ __attribute__((aligned(16))) unsigned char lds_raw[];
    LAS unsigned char* lds = (LAS unsigned char*)lds_raw;
    LAS unsigned char* scr = lds + SCR_OFF;
    cg::grid_group grid = cg::this_grid();
    const int tid = threadIdx.x, lane = tid & 63, wid = __builtin_amdgcn_readfirstlane(tid >> 6);
    const int G = gridDim.x, bx = blockIdx.x;
    const int vcu = (G % 8 == 0) ? (bx % 8) * (G / 8) + bx / 8 : bx;
    const int gw = vcu * 8 + wid, NGW = G * 8;
    const int lo = args.ph_lo, hi = args.ph_hi;
#define IN(k) (lo <= (k) && (k) < hi)
#define SEAM(k) do { if (IN(k) && IN((k) + 1)) grid.sync(); } while (0)

    const float* x_in = (const float*)args.in[0];
    const float* mem = (const float*)args.in[1];
    const int* positions = (const int*)args.in[2];
    const float* norm_mix_g = (const float*)args.in[3];
    const float* w_in = (const float*)args.in[4];
    const float* conv_w = (const float*)args.in[5];
    const float* sinks = (const float*)args.in[6];
    const float* gnorm_conv_g = (const float*)args.in[7];
    const float* gnorm_attn_g = (const float*)args.in[8];
    const float* w_out = (const float*)args.in[9];
    const float* norm_x_g = (const float*)args.in[10];
    const float* norm_mem_g = (const float*)args.in[11];
    const float* wx_q = (const float*)args.in[12];
    const float* wx_kv = (const float*)args.in[13];
    const float* wx_o = (const float*)args.in[14];
    const float* norm_mlp_g = (const float*)args.in[15];
    const float* w_up = (const float*)args.in[16];
    const float* w_down = (const float*)args.in[17];
    const float* final_g = (const float*)args.in[18];
    float* out = args.out;
    unsigned char* ws = args.ws;
    float* SSQ = (float*)(ws + WS_SSQ);
    bf16_t* XB = (bf16_t*)(ws + WS_XB);
    bf16_t* U = (bf16_t*)(ws + WS_U);
    bf16_t* MIX = (bf16_t*)(ws + WS_MIX);
    bf16_t* QX = (bf16_t*)(ws + WS_QX);
    bf16_t* PB = (bf16_t*)(ws + WS_P);
    bf16_t* OX = (bf16_t*)(ws + WS_OX);
    bf16_t* HB = (bf16_t*)(ws + WS_H);
    bf16_t* MEMN = (bf16_t*)(ws + WS_MEMN);
    float* ROT = (float*)(ws + WS_ROT);
#define WPTR(l, off) ((bf16_t*)(ws + WS_W + (size_t)(l) * LW_STRIDE + (off)))
#define KMEM(l) ((bf16_t*)(ws + WS_KMEM + (size_t)(l) * 2 * MiB))
#define VTM(l) ((bf16_t*)(ws + WS_VT + (size_t)(l) * 2 * MiB))

    if (IN(0)) {
        LAS float* tsc = (LAS float*)(lds + wid * 16384);
        constexpr int I_IN = 16 * 72, I_SQ = 16 * 32, I_KV = 16 * 64, I_UP = 16 * 128, I_DN = 64 * 32;
        constexpr int I_LAYER = I_IN + I_SQ + I_SQ + I_KV + I_SQ + I_UP + I_DN;
        for (int it = gw; it < DEPTH * I_LAYER; it += NGW) {
            const int l = it / I_LAYER; int r = it % I_LAYER;
            if (r < I_IN) { p0_transpose_item(w_in + (size_t)l * D * INC, D, INC, WPTR(l, LW_IN), norm_mix_g + l * D, nullptr, 1536, 2176, tsc, r, lane); continue; } r -= I_IN;
            if (r < I_SQ) { p0_transpose_item(w_out + (size_t)l * D * D, D, D, WPTR(l, LW_OUT), gnorm_conv_g + l * 512, gnorm_attn_g + l * 512, 0, 0, tsc, r, lane); continue; } r -= I_SQ;
            if (r < I_SQ) { p0_transpose_item(wx_q + (size_t)l * D * D, D, D, WPTR(l, LW_Q), norm_x_g + l * D, nullptr, 0, 0, tsc, r, lane); continue; } r -= I_SQ;
            if (r < I_KV) { p0_transpose_item(wx_kv + (size_t)l * D * 2 * D, D, 2 * D, WPTR(l, LW_KV), norm_mem_g + l * D, nullptr, 0, 0, tsc, r, lane); continue; } r -= I_KV;
            if (r < I_SQ) { p0_transpose_item(wx_o + (size_t)l * D * D, D, D, WPTR(l, LW_O), nullptr, nullptr, 0, 0, tsc, r, lane); continue; } r -= I_SQ;
            if (r < I_UP) { p0_transpose_item(w_up + (size_t)l * D * FF, D, FF, WPTR(l, LW_UP), norm_mlp_g + l * D, nullptr, 0, 0, tsc, r, lane); continue; } r -= I_UP;
            p0_transpose_item(w_down + (size_t)l * FF * D, FF, D, WPTR(l, LW_DN), nullptr, nullptr, 0, 0, tsc, r, lane);
        }
        for (int m = gw; m < T + MROWS; m += NGW) {
            const bool ismem = m >= T; const int row = ismem ? m - T : m;
            const f32x4* xr = (const f32x4*)((ismem ? mem : x_in) + (size_t)row * D) + lane;
            f32x4 v[4]; float s = 0.f;
#pragma unroll
            for (int j = 0; j < 4; ++j) { v[j] = xr[64 * j]; s += (v[j][0] * v[j][0] + v[j][1] * v[j][1]) + (v[j][2] * v[j][2] + v[j][3] * v[j][3]); }
            s = wave_sum(s);
            float rs = 1.0f;
            if (ismem) rs = 1.0f / sqrtf(s * (1.0f / 1024.0f) + EPS);
            else if (lane < 16) SSQ[(size_t)row * 16 + lane] = (lane == 0) ? s : 0.f;
            u32x2* o8 = (u32x2*)((ismem ? MEMN : XB) + (size_t)row * D) + lane;
#pragma unroll
            for (int j = 0; j < 4; ++j) { u32x2 w; w.x = pk2(v[j][0] * rs, v[j][1] * rs); w.y = pk2(v[j][2] * rs, v[j][3] * rs); o8[64 * j] = w; }
        }
        for (int idx = (vcu * 512 + tid); idx < T * 32; idx += G * 512) {
            const int tok = idx >> 5, i = idx & 31;
            double f = 1.0; for (int k = 0; k < i; ++k) f *= 0.74989420933245582730;
            const float inv = (float)f;
            const float ang = (float)positions[tok] * inv;
            double rev = (double)ang * 0.15915494309189533577; rev -= __builtin_rint(rev);
            const float rv = (float)rev;
            f32x2 cs = {__builtin_amdgcn_cosf(rv), __builtin_amdgcn_sinf(rv)};
            *(f32x2*)(ROT + (size_t)idx * 2) = cs;
        }
    }
    SEAM(0);

#pragma unroll 1
    for (int l = 0; l < DEPTH; ++l) {
        const int pb = 1 + 9 * l;
        if (IN(pb + 0)) {
            { pg8::Gemm g{XB, WPTR(l, LW_IN), D, D, D, T / 256, INC / 256, 0, 256L * D, 0, 1}; pg8::StaticOrder S; S.init(T / 256, INC / 256, G, bx);
              pg8::EpiWin E{U, SSQ, ROT}; pg8::gemm_phase(lds, scr, g, S, E); }
            if (l == 0) {
#pragma unroll 1
                for (int j = 0; j < 4; ++j) {
                    const int lj = j >> 1; const bool isv = j & 1;
                    const bf16_t* A = isv ? WPTR(lj, LW_KV) + (size_t)D * D : MEMN;
                    const bf16_t* Bt = isv ? MEMN : WPTR(lj, LW_KV);
                    pg8::Gemm g{A, Bt, D, D, D, 4, 4, 0, 256L * D, 0, 1}; pg8::StaticOrder S; S.init(4, 4, G, (bx + 4 * G - 64 - 16 * j) % G);
                    pg8::EpiScale<0> E{isv ? VTM(lj) : KMEM(lj), D, nullptr, 1.0f}; pg8::gemm_phase(lds, scr, g, S, E);
                }
            }
        }
        SEAM(pb + 0);
        if (IN(pb + 1)) {
            for (int unit = vcu; unit < NB * 64; unit += G) swa_conv_unit(unit, U, MIX, conv_w + l * 3 * 512, sinks + l * 8, lds);
        }
        SEAM(pb + 1);
        if (IN(pb + 2)) {
            pg8::Gemm g{MIX, WPTR(l, LW_OUT), D, D, D, T / 256, 4, 0, 256L * D, 0, 1}; pg8::StaticOrder S; S.init(T / 256, 4, G, bx);
            pg8::EpiResid E{l == 0 ? x_in : out, out, XB, SSQ}; pg8::gemm_phase(lds, scr, g, S, E);
        }
        SEAM(pb + 2);
        if (IN(pb + 3)) {
            pg8::Gemm g{XB, WPTR(l, LW_Q), D, D, D, T / 256, 4, 0, 256L * D, 0, 1}; pg8::StaticOrder S; S.init(T / 256, 4, G, bx);
            pg8::EpiScale<0> E{QX, D, SSQ, XSCALE}; pg8::gemm_phase(lds, scr, g, S, E);
        }
        SEAM(pb + 3);
        if (IN(pb + 4)) {
            pg8::Gemm g{QX, KMEM(l), 256, D, D, T / 256, 4, 256, 256, 256L * D, 16}; pg8::StaticOrder S; S.init(T / 256, 4, G, bx);
            pg8::EpiSoftmax E{PB, D}; pg8::gemm_phase(lds, scr, g, S, E);
        }
        SEAM(pb + 4);
        if (IN(pb + 5)) {
            pg8::Gemm g{PB, VTM(l), 256, D, D, T / 256, 4, 256, 256L * D, 256, 16}; pg8::StaticOrder S; S.init(T / 256, 4, G, bx);
            pg8::EpiScale<0> E{OX, D, nullptr, 1.0f}; pg8::gemm_phase(lds, scr, g, S, E);
        }
        SEAM(pb + 5);
        if (IN(pb + 6)) {
            pg8::Gemm g{OX, WPTR(l, LW_O), D, D, D, T / 256, 4, 0, 256L * D, 0, 1}; pg8::StaticOrder S; S.init(T / 256, 4, G, bx);
            pg8::EpiResid E{out, out, XB, SSQ}; pg8::gemm_phase(lds, scr, g, S, E);
        }
        SEAM(pb + 6);
        if (IN(pb + 7)) {
            pg8::Gemm g{XB, WPTR(l, LW_UP), D, D, D, T / 256, FF / 256, 0, 256L * D, 0, 1}; pg8::StaticOrder S; S.init(T / 256, FF / 256, G, bx);
            pg8::EpiScale<1> E{HB, FF, SSQ, 1.0f}; pg8::gemm_phase(lds, scr, g, S, E);
        }
        SEAM(pb + 7);
        if (IN(pb + 8)) {
            pg8::Gemm g{HB, WPTR(l, LW_DN), FF, FF, FF, T / 256, 4, 0, 256L * FF, 0, 1}; pg8::StaticOrder S; S.init(T / 256, 4, G, bx);
            pg8::EpiResid E{out, out, XB, SSQ}; pg8::gemm_phase(lds, scr, g, S, E);
        }
        SEAM(pb + 8);
    }
    if (IN(19)) {
        for (int m = gw; m < T; m += NGW) {
            const float rs = row_rstd(SSQ, m);
            f32x4* xr = (f32x4*)(out + (size_t)m * D) + lane; const f32x4* gr = (const f32x4*)final_g + lane;
#pragma unroll
            for (int j = 0; j < 4; ++j) { const f32x4 v = xr[64 * j], gv = gr[64 * j]; xr[64 * j] = v * rs * gv; }
        }
    }
#undef IN
#undef SEAM
}

extern "C" void kernel_launch(void* const* d_in, const int* in_sizes, int n_in, void* d_out, int out_size, void* d_ws, size_t ws_size, hipStream_t stream) {
    static int grid = 0;
    if (grid == 0) {
        if (n_in != 19 || in_sizes[0] != T * D || out_size != T * D || ws_size < WS_END) { fprintf(stderr, "kernel_launch: unexpected shapes (n_in %d, in0 %d, out %d, ws %zu)\n", n_in, n_in > 0 ? in_sizes[0] : -1, out_size, ws_size); grid = -1; return; }
        int dev = 0, cus = 0, per_cu = 0;
        if (hipGetDevice(&dev) != hipSuccess || hipDeviceGetAttribute(&cus, hipDeviceAttributeMultiprocessorCount, dev) != hipSuccess) { grid = -1; return; }
        if (hipFuncSetAttribute((const void*)mk_fwd, hipFuncAttributeMaxDynamicSharedMemorySize, LDS_BYTES) != hipSuccess) { fprintf(stderr, "kernel_launch: hipFuncSetAttribute failed\n"); grid = -1; return; }
        if (hipOccupancyMaxActiveBlocksPerMultiprocessor(&per_cu, (const void*)mk_fwd, 512, LDS_BYTES) != hipSuccess || per_cu < 1) { fprintf(stderr, "kernel_launch: occupancy query failed (%d)\n", per_cu); (void)hipGetLastError(); grid = -1; return; }
        grid = cus * per_cu;
    }
    if (grid < 0) return;
    Args a{};
    for (int i = 0; i < 19; ++i) a.in[i] = d_in[i];
    a.out = (float*)d_out; a.ws = (unsigned char*)d_ws;
#if MK_MULTI
    for (int p = 0; p < N_PHASES; ++p) {
        a.ph_lo = p; a.ph_hi = p + 1;
        hipLaunchKernelGGL(mk_fwd, dim3(grid), dim3(512), LDS_BYTES, stream, a);
    }
#else
    a.ph_lo = 0; a.ph_hi = N_PHASES;
    void* kargs[] = {&a};
    hipError_t e = hipLaunchCooperativeKernel((const void*)mk_fwd, dim3(grid), dim3(512), kargs, LDS_BYTES, stream);
    if (e != hipSuccess) fprintf(stderr, "cooperative launch failed: %s (grid %d)\n", hipGetErrorString(e), grid);
#endif
}
```

```cpp
#include <hip/hip_runtime.h>
#include <hip/hip_cooperative_groups.h>
#include <cstdio>
#include <cstdint>
namespace cg = cooperative_groups;

#ifndef REP0
#define REP0 1
#endif
#ifndef REP1
#define REP1 1
#endif
#ifndef REP2
#define REP2 1
#endif
#ifndef REP4
#define REP4 1
#endif
#ifndef REP5
#define REP5 1
#endif
#ifndef REP7
#define REP7 1
#endif
#ifndef FORCE_FALLBACK
#define FORCE_FALLBACK 0
#endif
#ifndef MK_MULTI
#define MK_MULTI 0
#endif

#define DI __device__ __forceinline__
#define LAS __attribute__((address_space(3)))
typedef unsigned short bf16_t;
typedef short bf16x8 __attribute__((ext_vector_type(8)));
typedef short s16x4 __attribute__((ext_vector_type(4)));
typedef float f32x2 __attribute__((ext_vector_type(2)));
typedef float f32x4 __attribute__((ext_vector_type(4)));
typedef float f32x16 __attribute__((ext_vector_type(16)));
typedef unsigned u32x2 __attribute__((ext_vector_type(2)));
typedef unsigned u32x4 __attribute__((ext_vector_type(4)));
typedef __bf16 bf16x2_t __attribute__((ext_vector_type(2)));

constexpr int NB = 4, SEQ = 4096, T = NB * SEQ, D = 1024, NMEM = 256, MROWS = NB * NMEM, INC = 2304, FF = 4096, DEPTH = 2;
constexpr float EPS = 1e-6f, LOG2E = 1.4426950408889634f;
constexpr float QSCALE = 0.125f * LOG2E;
constexpr float XSCALE = 0.0625f * LOG2E;

constexpr size_t MiB = 1u << 20;
constexpr size_t WS_SSQ = 1 * MiB;
constexpr size_t WS_W = 2 * MiB;
constexpr size_t LW_IN = 0, LW_OUT = 9 * MiB / 2, LW_Q = 13 * MiB / 2, LW_KV = 17 * MiB / 2, LW_O = 25 * MiB / 2, LW_UP = 29 * MiB / 2, LW_DN = 45 * MiB / 2, LW_STRIDE = 61 * MiB / 2;
constexpr size_t WS_XB = 64 * MiB;
constexpr size_t WS_U = 96 * MiB;
constexpr size_t WS_MIX = 168 * MiB;
constexpr size_t WS_QX = 96 * MiB, WS_P = 128 * MiB, WS_OX = 168 * MiB;
constexpr size_t WS_H = 96 * MiB;
constexpr size_t WS_KMEM = 224 * MiB;
constexpr size_t WS_VT = 228 * MiB;
constexpr size_t WS_MEMN = 232 * MiB;
constexpr size_t WS_ROT = 234 * MiB;
constexpr size_t WS_VP = 238 * MiB;
constexpr size_t WS_END = 254 * MiB;

constexpr int RING_BYTES = 131072, SCR_OFF = RING_BYTES + 1024, LDS_BYTES = 147456;

DI unsigned pk2(float lo, float hi) { f32x2 v = {lo, hi}; bf16x2_t b = __builtin_convertvector(v, bf16x2_t); return __builtin_bit_cast(unsigned, b); }
DI float bf_lo(unsigned w) { return __uint_as_float(w << 16); }
DI float bf_hi(unsigned w) { return __uint_as_float(w & 0xffff0000u); }
DI float row_rstd(const float* ssq, int row) {
    const f32x4* p = (const f32x4*)(ssq + (size_t)row * 16);
    const f32x4 a = p[0], b = p[1], c = p[2], d = p[3];
    const float s = ((a[0] + a[1]) + (a[2] + a[3])) + ((b[0] + b[1]) + (b[2] + b[3])) + ((c[0] + c[1]) + (c[2] + c[3])) + ((d[0] + d[1]) + (d[2] + d[3]));
    return 1.0f / sqrtf(s * (1.0f / 1024.0f) + EPS);
}

DI void team_barrier_at(unsigned* cnt, unsigned* bar, unsigned gen);

namespace pg8 {
constexpr int BM = 256, BK = 64, HALF = 128, HTB = HALF * BK * 2, NXCD = 8, WGM = 8;
__host__ __device__ __forceinline__ int lds_byte(int r, int c) { const int st = (r >> 4) * 2 + (c >> 5), rr = r & 15, cc = c & 31, ob = rr * 64 + cc * 2; return st * 1024 + (ob ^ (((ob >> 9) & 1) << 5)); }
__host__ __device__ __forceinline__ void stage_rc(int b, int& R, int& C) { const int st = b / 1024, sb = b % 1024, swz = sb ^ (((sb >> 9) & 1) << 5); R = (st >> 1) * 16 + swz / 64; C = (st & 1) * 32 + (swz % 64) / 2; }
__host__ __device__ __forceinline__ int perm32(int rho) { const int n = rho >> 4, i = rho & 15; return 8 * (i >> 2) + 4 * n + (i & 3); }

struct Unit { int pm, pn; };
struct Gemm { const bf16_t* A; const bf16_t* Bt; int K, lda, ldb, nM, nN; int a_div; long a_s1, a_s2, a_s3; int b_div; long b_s1, b_s2, b_s3; };
DI Gemm std_gemm(const bf16_t* A, const bf16_t* Bt, int K, int lda, int ldb, int nM, int nN) { return Gemm{A, Bt, K, lda, ldb, nM, nN, 1, 256L * lda, 0, 0, 1, 0, 0, 256L * ldb}; }
DI const char* abase(const Gemm& g, const Unit& u) { return (const char*)(g.A + (size_t)(u.pm / g.a_div) * g.a_s1 + (size_t)(u.pm % g.a_div) * g.a_s2 + (size_t)u.pn * g.a_s3); }
DI const char* bbase(const Gemm& g, const Unit& u) { return (const char*)(g.Bt + (size_t)(u.pm / g.b_div) * g.b_s1 + (size_t)(u.pm % g.b_div) * g.b_s2 + (size_t)u.pn * g.b_s3); }

struct StaticOrder {
    int nM, nN, nwg, G, c;
    DI void init(int nM_, int nN_, int G_, int c_) { nM = nM_; nN = nN_; nwg = nM * nN; G = G_; c = c_; }
    DI bool next(int i, Unit& u) const {
        const long L = (long)i * G + c; if (L >= nwg) return false;
        int wgid = (int)L; { const int q = nwg / NXCD, r = nwg % NXCD, xcd = wgid % NXCD, off = wgid / NXCD; wgid = (xcd < r ? xcd * (q + 1) : r * (q + 1) + (xcd - r) * q) + off; }
        const int nig = WGM * nN, gid = wgid / nig, fm = gid * WGM, gsz = (nM - fm) < WGM ? (nM - fm) : WGM;
        u.pm = fm + ((wgid % nig) % gsz); u.pn = (wgid % nig) / gsz; return true;
    }
};

typedef f32x4 Acc[2][2][4][2];

template <int ACT> struct EpiScale {
    static constexpr bool PERM = true;
    bf16_t* O; int ldc; const float* ssq; float scale; int pm0 = -1;
    DI void operator()(Acc& acc, const Unit& u, int wr, int wc, int fr, int fq, LAS unsigned char* scr) const {
        const int row0 = u.pm * BM + wr * 64 + fr, col0 = u.pn * BM + wc * 32 + 8 * fq;
        const LAS float* tab = (const LAS float*)(scr + 8192);
#pragma unroll
        for (int ai = 0; ai < 2; ++ai)
#pragma unroll
            for (int m = 0; m < 4; ++m) {
                const int row = row0 + ai * HALF + m * 16;
                const float rs = ssq ? ((u.pm == pm0) ? tab[ai * HALF + wr * 64 + m * 16 + fr] : row_rstd(ssq, row)) * scale : scale;
                bf16_t* rowp = O + (size_t)row * ldc + col0;
#pragma unroll
                for (int bj = 0; bj < 2; ++bj) {
                    f32x4 v0 = acc[ai][bj][m][0] * rs, v1 = acc[ai][bj][m][1] * rs;
                    if (ACT == 1) {
#pragma unroll
                        for (int e = 0; e < 4; ++e) { const float a = fmaxf(v0[e], 0.f), b = fmaxf(v1[e], 0.f); v0[e] = a * a; v1[e] = b * b; }
                    }
                    u32x4 w; w.x = pk2(v0[0], v0[1]); w.y = pk2(v0[2], v0[3]); w.z = pk2(v1[0], v1[1]); w.w = pk2(v1[2], v1[3]);
                    *(u32x4*)(rowp + bj * HALF) = w;
                }
            }
    }
};

struct EpiWin {
    static constexpr bool PERM = true;
    bf16_t* U; const float* ssq; const float* rot; int pm0 = -1; unsigned* war = nullptr; unsigned war_target = 0u; unsigned* barw = nullptr;
    DI void operator()(Acc& acc, const Unit& u, int wr, int wc, int fr, int fq, LAS unsigned char* scr) const {
        const LAS float* tab = (const LAS float*)(scr + 8192);
        if (war) {
            unsigned sp = 0u;
            while (__hip_atomic_load(war, __ATOMIC_RELAXED, __HIP_MEMORY_SCOPE_AGENT) < war_target) {
                __builtin_amdgcn_s_sleep(1);
                if ((++sp & 255u) == 0u) { if (__hip_atomic_load(barw + 128, __ATOMIC_RELAXED, __HIP_MEMORY_SCOPE_AGENT)) break; if (sp > (1u << 18)) { atomicAdd(barw + 128, 1u); break; } }
            }
        }
        const int row0 = u.pm * BM + wr * 64 + fr, col0 = u.pn * BM + wc * 32 + 8 * fq;
        const bool isq = (u.pn == 6) || (u.pn == 7), isk8 = (u.pn == 8);
        const int i0 = 16 * (wc & 1) + 4 * fq;
#pragma unroll
        for (int ai = 0; ai < 2; ++ai)
#pragma unroll
            for (int m = 0; m < 4; ++m) {
                const int row = row0 + ai * HALF + m * 16;
                const float rs = (u.pm == pm0) ? tab[ai * HALF + wr * 64 + m * 16 + fr] : row_rstd(ssq, row);
                bf16_t* rowp = U + (size_t)row * INC + col0;
                f32x4 cs0 = {1.f, 0.f, 1.f, 0.f}, cs1 = {1.f, 0.f, 1.f, 0.f};
                if (isq || isk8) { const f32x4* rp = (const f32x4*)(rot + ((size_t)row * 32 + i0) * 2); cs0 = rp[0]; cs1 = rp[1]; }
#pragma unroll
                for (int bj = 0; bj < 2; ++bj) {
                    f32x4 v0 = acc[ai][bj][m][0] * rs, v1 = acc[ai][bj][m][1] * rs;
                    if (isq || (isk8 && bj == 0)) {
                        const float sc = isq ? QSCALE : 1.0f;
                        f32x4 r0, r1;
                        r0[0] = (v0[0] * cs0[0] - v0[1] * cs0[1]) * sc; r0[1] = (v0[1] * cs0[0] + v0[0] * cs0[1]) * sc;
                        r0[2] = (v0[2] * cs0[2] - v0[3] * cs0[3]) * sc; r0[3] = (v0[3] * cs0[2] + v0[2] * cs0[3]) * sc;
                        r1[0] = (v1[0] * cs1[0] - v1[1] * cs1[1]) * sc; r1[1] = (v1[1] * cs1[0] + v1[0] * cs1[1]) * sc;
                        r1[2] = (v1[2] * cs1[2] - v1[3] * cs1[3]) * sc; r1[3] = (v1[3] * cs1[2] + v1[2] * cs1[3]) * sc;
                        v0 = r0; v1 = r1;
                    }
                    u32x4 w; w.x = pk2(v0[0], v0[1]); w.y = pk2(v0[2], v0[3]); w.z = pk2(v1[0], v1[1]); w.w = pk2(v1[2], v1[3]);
                    *(u32x4*)(rowp + bj * HALF) = w;
                }
            }
    }
};

template <int MODE> struct EpiResid {
    static constexpr bool PERM = true;
    const float* basef; float* out; bf16_t* xb; float* ssq;
    DI void operator()(Acc& acc, const Unit& u, int wr, int wc, int fr, int fq, LAS unsigned char*) const {
        const int row0 = u.pm * BM + wr * 64 + fr, col0 = u.pn * BM + wc * 32 + 8 * fq;
#pragma unroll
        for (int ai = 0; ai < 2; ++ai)
#pragma unroll
            for (int m = 0; m < 4; ++m) {
                const int row = row0 + ai * HALF + m * 16; const size_t off = (size_t)row * D + col0;
                float s = 0.f;
#pragma unroll
                for (int bj = 0; bj < 2; ++bj) {
                    f32x4 b0, b1;
                    if (MODE == 0) { b0 = __builtin_nontemporal_load((const f32x4*)(basef + off + bj * HALF)); b1 = __builtin_nontemporal_load((const f32x4*)(basef + off + bj * HALF + 4)); }
                    else { const u32x4 w = *(const u32x4*)(xb + off + bj * HALF); b0 = (f32x4){bf_lo(w.x), bf_hi(w.x), bf_lo(w.y), bf_hi(w.y)}; b1 = (f32x4){bf_lo(w.z), bf_hi(w.z), bf_lo(w.w), bf_hi(w.w)}; }
                    const f32x4 o0 = b0 + acc[ai][bj][m][0], o1 = b1 + acc[ai][bj][m][1];
                    if (MODE == 2) {
                        *(f32x4*)(out + off + bj * HALF) = o0; *(f32x4*)(out + off + bj * HALF + 4) = o1;
                        s += ((o0[0] * o0[0] + o0[1] * o0[1]) + (o0[2] * o0[2] + o0[3] * o0[3])) + ((o1[0] * o1[0] + o1[1] * o1[1]) + (o1[2] * o1[2] + o1[3] * o1[3]));
                    } else {
                        u32x4 w; w.x = pk2(o0[0], o0[1]); w.y = pk2(o0[2], o0[3]); w.z = pk2(o1[0], o1[1]); w.w = pk2(o1[2], o1[3]);
                        *(u32x4*)(xb + off + bj * HALF) = w;
                        const float r0 = bf_lo(w.x), r1 = bf_hi(w.x), r2 = bf_lo(w.y), r3 = bf_hi(w.y), r4 = bf_lo(w.z), r5 = bf_hi(w.z), r6 = bf_lo(w.w), r7 = bf_hi(w.w);
                        s += ((r0 * r0 + r1 * r1) + (r2 * r2 + r3 * r3)) + ((r4 * r4 + r5 * r5) + (r6 * r6 + r7 * r7));
                    }
                }
                s += __shfl_xor(s, 16); s += __shfl_xor(s, 32);
                if (fq == 0) ssq[(size_t)row * 16 + u.pn * 4 + wc] = s;
            }
    }
};

struct EpiFinal {
    static constexpr bool PERM = true;
    float* out; const bf16_t* xb; float* ssq; const float* fg; unsigned* tcnt; unsigned* barw; unsigned gen;
    DI void operator()(Acc& acc, const Unit& u, int wr, int wc, int fr, int fq, LAS unsigned char*) const {
        const int row0 = u.pm * BM + wr * 64 + fr, col0 = u.pn * BM + wc * 32 + 8 * fq;
#pragma unroll
        for (int ai = 0; ai < 2; ++ai)
#pragma unroll
            for (int m = 0; m < 4; ++m) {
                const int row = row0 + ai * HALF + m * 16; const size_t off = (size_t)row * D + col0;
                float s = 0.f;
#pragma unroll
                for (int bj = 0; bj < 2; ++bj) {
                    const u32x4 w = *(const u32x4*)(xb + off + bj * HALF);
                    const f32x4 o0 = (f32x4){bf_lo(w.x), bf_hi(w.x), bf_lo(w.y), bf_hi(w.y)} + acc[ai][bj][m][0], o1 = (f32x4){bf_lo(w.z), bf_hi(w.z), bf_lo(w.w), bf_hi(w.w)} + acc[ai][bj][m][1];
                    acc[ai][bj][m][0] = o0; acc[ai][bj][m][1] = o1;
                    s += ((o0[0] * o0[0] + o0[1] * o0[1]) + (o0[2] * o0[2] + o0[3] * o0[3])) + ((o1[0] * o1[0] + o1[1] * o1[1]) + (o1[2] * o1[2] + o1[3] * o1[3]));
                }
                s += __shfl_xor(s, 16); s += __shfl_xor(s, 32);
                if (fq == 0) ssq[(size_t)row * 16 + u.pn * 4 + wc] = s;
            }
        team_barrier_at(tcnt, barw, gen);
        f32x4 gv[2][2];
#pragma unroll
        for (int bj = 0; bj < 2; ++bj) { gv[bj][0] = *(const f32x4*)(fg + col0 + bj * HALF); gv[bj][1] = *(const f32x4*)(fg + col0 + bj * HALF + 4); }
#pragma unroll
        for (int ai = 0; ai < 2; ++ai)
#pragma unroll
            for (int m = 0; m < 4; ++m) {
                const int row = row0 + ai * HALF + m * 16; const size_t off = (size_t)row * D + col0;
                const float rs = row_rstd(ssq, row);
#pragma unroll
                for (int bj = 0; bj < 2; ++bj) {
                    __builtin_nontemporal_store(acc[ai][bj][m][0] * rs * gv[bj][0], (f32x4*)(out + off + bj * HALF));
                    __builtin_nontemporal_store(acc[ai][bj][m][1] * rs * gv[bj][1], (f32x4*)(out + off + bj * HALF + 4));
                }
            }
    }
};

struct EpiSoftmax {
    static constexpr bool PERM = true;
    bf16_t* P; int ldc; const float* ssq; float scale; int pm0;
    DI void operator()(Acc& acc, const Unit& u, int wr, int wc, int fr, int fq, LAS unsigned char* scr) const {
        LAS f32x2* X = (LAS f32x2*)scr;
        const LAS float* tab = (const LAS float*)(scr + 8192);
        float mw[2][4];
#pragma unroll
        for (int ai = 0; ai < 2; ++ai)
#pragma unroll
            for (int m = 0; m < 4; ++m) {
                const float rs = ((u.pm == pm0) ? tab[ai * HALF + wr * 64 + m * 16 + fr] : row_rstd(ssq, u.pm * BM + ai * HALF + wr * 64 + m * 16 + fr)) * scale;
#pragma unroll
                for (int bj = 0; bj < 2; ++bj)
#pragma unroll
                    for (int n = 0; n < 2; ++n) acc[ai][bj][m][n] = acc[ai][bj][m][n] * rs;
                float mx = -INFINITY;
#pragma unroll
                for (int bj = 0; bj < 2; ++bj)
#pragma unroll
                    for (int n = 0; n < 2; ++n)
#pragma unroll
                        for (int e = 0; e < 4; ++e) mx = fmaxf(mx, acc[ai][bj][m][n][e]);
                mx = fmaxf(mx, __shfl_xor(mx, 16)); mx = fmaxf(mx, __shfl_xor(mx, 32));
                float s = 0.f;
#pragma unroll
                for (int bj = 0; bj < 2; ++bj)
#pragma unroll
                    for (int n = 0; n < 2; ++n)
#pragma unroll
                        for (int e = 0; e < 4; ++e) { const float p = __builtin_amdgcn_exp2f(acc[ai][bj][m][n][e] - mx); acc[ai][bj][m][n][e] = p; s += p; }
                s += __shfl_xor(s, 16); s += __shfl_xor(s, 32);
                mw[ai][m] = mx;
                if (fq == 0) X[(ai * HALF + wr * 64 + m * 16 + fr) * 4 + wc] = (f32x2){mx, s};
            }
        asm volatile("s_waitcnt lgkmcnt(0)" ::: "memory"); __builtin_amdgcn_s_barrier(); asm volatile("" ::: "memory");
        const int row0 = u.pm * BM + wr * 64 + fr, col0 = u.pn * BM + wc * 32 + 8 * fq;
#pragma unroll
        for (int ai = 0; ai < 2; ++ai)
#pragma unroll
            for (int m = 0; m < 4; ++m) {
                const int rl = ai * HALF + wr * 64 + m * 16 + fr;
                const f32x2 a = X[rl * 4 + 0], b = X[rl * 4 + 1], c = X[rl * 4 + 2], d = X[rl * 4 + 3];
                const float M = fmaxf(fmaxf(a.x, b.x), fmaxf(c.x, d.x));
                const float tot = a.y * __builtin_amdgcn_exp2f(a.x - M) + b.y * __builtin_amdgcn_exp2f(b.x - M) + c.y * __builtin_amdgcn_exp2f(c.x - M) + d.y * __builtin_amdgcn_exp2f(d.x - M);
                const float sc = __builtin_amdgcn_exp2f(mw[ai][m] - M) / tot;
                bf16_t* rowp = P + (size_t)(row0 + ai * HALF + m * 16) * ldc + col0;
#pragma unroll
                for (int bj = 0; bj < 2; ++bj) {
                    const f32x4 v0 = acc[ai][bj][m][0] * sc, v1 = acc[ai][bj][m][1] * sc;
                    u32x4 w; w.x = pk2(v0[0], v0[1]); w.y = pk2(v0[2], v0[3]); w.z = pk2(v1[0], v1[1]); w.w = pk2(v1[2], v1[3]);
                    *(u32x4*)(rowp + bj * HALF) = w;
                }
            }
        asm volatile("s_waitcnt lgkmcnt(0)" ::: "memory"); __builtin_amdgcn_s_barrier(); asm volatile("" ::: "memory");
    }
};

template <class Epi>
DI void gemm_phase(LAS unsigned char* lds, LAS unsigned char* scr, const Gemm g, const StaticOrder& S, const Epi& E) {
    int tid = threadIdx.x; asm volatile("" : "+v"(tid));
    const int wid = __builtin_amdgcn_readfirstlane(tid >> 6), lane = tid & 63, wr = wid >> 2, wc = wid & 3, fr = lane & 15, fq = lane >> 4;
    const int nt = g.K / BK;
    unsigned voffA[2], voffB[2];
#pragma unroll
    for (int i = 0; i < 2; ++i) { int R, C; stage_rc(tid * 16 + i * 8192, R, C); const int Rb = Epi::PERM ? ((R & ~31) + perm32(R & 31)) : R;
        voffA[i] = (unsigned)(R * g.lda + C) * 2u; voffB[i] = (unsigned)(Rb * g.ldb + C) * 2u; }
    const size_t kstep = (size_t)(BK * 2);
    const size_t hsA = (size_t)HALF * g.lda * 2, hsB = (size_t)HALF * g.ldb * 2;
    const unsigned ldsw = (unsigned)wid * 1024u;
    const int aoff = lds_byte(wr * 64 + fr, fq * 8), boff = lds_byte(wc * 32 + fr, fq * 8);
#define PG8_SA(b, h) (((b) * 2 + (h)) * HTB)
#define PG8_SB(b, h) ((4 + (b) * 2 + (h)) * HTB)
#define PG8_STAGE(bufoff, gbase, voff) do { _Pragma("unroll") for (int _i = 0; _i < 2; ++_i) \
        __builtin_amdgcn_global_load_lds((const unsigned*)((const char*)(gbase) + (voff)[_i]), (LAS unsigned*)(lds + (bufoff) + ldsw + _i * 8192), 16, 0, 0); } while (0)
#define PG8_LDA(dst, b, h) do { _Pragma("unroll") for (int m = 0; m < 4; ++m) _Pragma("unroll") for (int k = 0; k < 2; ++k) dst[m][k] = *(const LAS bf16x8*)(lds + PG8_SA(b, h) + aoff + m * 2048 + k * 1024); } while (0)
#define PG8_LDB(dst, b, h) do { _Pragma("unroll") for (int n = 0; n < 2; ++n) _Pragma("unroll") for (int k = 0; k < 2; ++k) dst[n][k] = *(const LAS bf16x8*)(lds + PG8_SB(b, h) + boff + n * 2048 + k * 1024); } while (0)
#define PG8_MMA(ai, bj, At, Bt) do { __builtin_amdgcn_s_setprio(1); _Pragma("unroll") for (int m = 0; m < 4; ++m) _Pragma("unroll") for (int n = 0; n < 2; ++n) _Pragma("unroll") for (int k = 0; k < 2; ++k) \
        acc[ai][bj][m][n] = __builtin_amdgcn_mfma_f32_16x16x32_bf16(Bt[n][k], At[m][k], acc[ai][bj][m][n], 0, 0, 0); __builtin_amdgcn_s_setprio(0); } while (0)
#define PG8_WAIT_V(n) asm volatile("s_waitcnt vmcnt(" #n ")" ::: "memory")
#define PG8_WAIT_L(n) asm volatile("s_waitcnt lgkmcnt(" #n ")" ::: "memory")
#define PG8_BAR __builtin_amdgcn_s_barrier()
#define PG8_SCHED __builtin_amdgcn_sched_barrier(0)
    Unit cur, nxt; int ui = 0;
    if (!S.next(0, cur)) return;
    Acc acc;
#pragma unroll
    for (int a = 0; a < 2; ++a)
#pragma unroll
        for (int b = 0; b < 2; ++b)
#pragma unroll
            for (int m = 0; m < 4; ++m)
#pragma unroll
                for (int n = 0; n < 2; ++n) acc[a][b][m][n] = (f32x4){0.f, 0.f, 0.f, 0.f};
    bf16x8 At[4][2], B0[2][2], B1[2][2];
    const char* cA = abase(g, cur); const char* cB = bbase(g, cur);
    PG8_STAGE(PG8_SB(0, 0), cB, voffB); PG8_STAGE(PG8_SB(0, 1), cB + hsB, voffB); PG8_STAGE(PG8_SA(0, 0), cA, voffA); PG8_STAGE(PG8_SA(0, 1), cA + hsA, voffA);
    if (wr == 1) PG8_BAR;
    PG8_WAIT_V(2); PG8_BAR;
    PG8_STAGE(PG8_SB(1, 0), cB + kstep, voffB); PG8_STAGE(PG8_SA(1, 0), cA + kstep, voffA); PG8_STAGE(PG8_SB(1, 1), cB + hsB + kstep, voffB);
    PG8_WAIT_V(6); PG8_BAR;
    for (;;) {
        const bool has_next = S.next(ui + 1, nxt);
        const char* nA = has_next ? abase(g, nxt) : cA; const char* nB = has_next ? bbase(g, nxt) : cB;
        for (int t = 0; t < nt; t += 2) {
            const bool last = (t == nt - 2);
            const char* a1 = cA + (size_t)(t + 1) * kstep;
            const char* a2 = last ? nA : cA + (size_t)(t + 2) * kstep; const char* b2 = last ? nB : cB + (size_t)(t + 2) * kstep;
            const char* a3 = a2 + kstep; const char* b3 = b2 + kstep;
            PG8_LDB(B0, 0, 0); PG8_LDB(B1, 0, 1); PG8_SCHED; PG8_LDA(At, 0, 0); PG8_STAGE(PG8_SA(1, 1), a1 + hsA, voffA);
            PG8_WAIT_V(8); PG8_WAIT_L(0); PG8_BAR; PG8_MMA(0, 0, At, B0); PG8_MMA(0, 1, At, B1); PG8_BAR; PG8_SCHED;
            PG8_LDA(At, 0, 1); PG8_STAGE(PG8_SB(0, 0), b2, voffB); PG8_STAGE(PG8_SB(0, 1), b2 + hsB, voffB); PG8_STAGE(PG8_SA(0, 0), a2, voffA);
            PG8_WAIT_V(8); PG8_WAIT_L(0); PG8_BAR; PG8_MMA(1, 0, At, B0); PG8_MMA(1, 1, At, B1); PG8_BAR; PG8_SCHED;
            PG8_LDB(B0, 1, 0); PG8_LDB(B1, 1, 1); PG8_SCHED; PG8_LDA(At, 1, 0); PG8_STAGE(PG8_SA(0, 1), a2 + hsA, voffA);
            PG8_WAIT_V(8); PG8_WAIT_L(0); PG8_BAR; PG8_MMA(0, 0, At, B0); PG8_MMA(0, 1, At, B1); PG8_BAR; PG8_SCHED;
            PG8_LDA(At, 1, 1); PG8_STAGE(PG8_SB(1, 0), b3, voffB); PG8_STAGE(PG8_SB(1, 1), b3 + hsB, voffB); PG8_STAGE(PG8_SA(1, 0), a3, voffA);
            PG8_WAIT_V(8); PG8_WAIT_L(0); PG8_BAR; PG8_MMA(1, 0, At, B0); PG8_MMA(1, 1, At, B1); PG8_BAR; PG8_SCHED;
        }
        if (wr == 0) PG8_BAR;
        E(acc, cur, wr, wc, fr, fq, scr);
        if (!has_next) break;
#pragma unroll
        for (int a = 0; a < 2; ++a)
#pragma unroll
            for (int b = 0; b < 2; ++b)
#pragma unroll
                for (int m = 0; m < 4; ++m)
#pragma unroll
                    for (int n = 0; n < 2; ++n) acc[a][b][m][n] = (f32x4){0.f, 0.f, 0.f, 0.f};
        cur = nxt; cA = nA; cB = nB; ++ui;
        if (wr == 1) PG8_BAR;
    }
    PG8_WAIT_V(0);
    PG8_BAR;
#undef PG8_SA
#undef PG8_SB
#undef PG8_STAGE
#undef PG8_LDA
#undef PG8_LDB
#undef PG8_MMA
#undef PG8_WAIT_V
#undef PG8_WAIT_L
#undef PG8_BAR
#undef PG8_SCHED
}
}

DI float wave_sum(float v) {
#pragma unroll
    for (int o = 1; o < 64; o <<= 1) v += __shfl_xor(v, o);
    return v;
}
struct TItem { const float* W; bf16_t* WT; const float* g; const float* g2; int K, N, rot_lo, rot_hi, item; };
DI void p0_item_load(const TItem& t, float (&v)[32], int lane) {
    const int nblk = t.N / 32, kb = t.item / nblk, nb = t.item % nblk, k0 = 64 * kb, n0 = 32 * nb;
    const int nc = lane & 7;
    const bool rot = n0 >= t.rot_lo && n0 < t.rot_hi;
    const int c0 = rot ? (n0 & ~63) + 32 * (nc >> 2) + ((n0 & 63) >> 1) + 4 * (nc & 3) : n0 + 4 * nc;
#pragma unroll
    for (int i = 0; i < 8; ++i) {
        const int k = k0 + 8 * i + (lane >> 3);
        float gv = 1.0f;
        if (t.g) gv = (t.g2 && k >= 512) ? t.g2[k - 512] : t.g[k];
        const f32x4 w = __builtin_nontemporal_load((const f32x4*)(t.W + (size_t)k * t.N + c0));
        v[4 * i + 0] = w[0] * gv; v[4 * i + 1] = w[1] * gv; v[4 * i + 2] = w[2] * gv; v[4 * i + 3] = w[3] * gv;
    }
}
DI void p0_item_finish(const TItem& t, const float (&v)[32], LAS float* scr, int lane) {
    const int nblk = t.N / 32, kb = t.item / nblk, nb = t.item % nblk, k0 = 64 * kb, n0 = 32 * nb;
    const int nc = lane & 7;
    const bool rot = n0 >= t.rot_lo && n0 < t.rot_hi;
    const int d0 = rot ? 8 * (nc & 3) + (nc >> 2) : 4 * nc, ds = rot ? 2 : 1;
#pragma unroll
    for (int i = 0; i < 8; ++i)
#pragma unroll
        for (int e = 0; e < 4; ++e) scr[(8 * i + (lane >> 3)) * 33 + d0 + e * ds] = v[4 * i + e];
    asm volatile("s_waitcnt lgkmcnt(0)" ::: "memory");
    const int c = lane & 7;
#pragma unroll
    for (int j = 0; j < 4; ++j) { const int n = (lane >> 3) + 8 * j; const LAS float* s = scr + (8 * c) * 33 + n;
        u32x4 o; o.x = pk2(s[0 * 33], s[1 * 33]); o.y = pk2(s[2 * 33], s[3 * 33]); o.z = pk2(s[4 * 33], s[5 * 33]); o.w = pk2(s[6 * 33], s[7 * 33]);
        *(u32x4*)(t.WT + (size_t)(n0 + n) * t.K + k0 + 8 * c) = o; }
    asm volatile("s_waitcnt lgkmcnt(0)" ::: "memory");
}

constexpr int SW_KOFF = 0, SW_KSTR = 272, SW_VOFF = 192 * 272, SW_VSTR = 320, SW_XOFF = SW_VOFF + 192 * 320;
static_assert(SW_XOFF + 2 * 32 * 8 * 4 <= RING_BYTES, "swa LDS");
DI int crow(int r, int hi) { return (r & 3) + 8 * (r >> 2) + 4 * hi; }
typedef short v4i16_t __attribute__((ext_vector_type(4)));
DI s16x4 vtr(LAS unsigned char* p) { return __builtin_bit_cast(s16x4, __builtin_amdgcn_ds_read_tr16_b64_v4i16((LAS v4i16_t*)p)); }

DI void swa_conv_unit(int unit, const bf16_t* U, bf16_t* MIX, const float* convw, const float* sinks, LAS unsigned char* lds) {
    int tid = threadIdx.x; asm volatile("" : "+v"(tid));
    const int lane = tid & 63, wid = __builtin_amdgcn_readfirstlane(tid >> 6);
    const int b = unit >> 6, qt = unit & 63, q0s = qt * 64, tok0 = b * SEQ + q0s;
#pragma unroll
    for (int it = 0; it < 6; ++it) {
        const int id = it * 512 + tid, key = id >> 4, ch = id & 15;
        u32x4 kv = {0u, 0u, 0u, 0u}, vv = {0u, 0u, 0u, 0u};
        if (q0s - 128 + key >= 0) { const bf16_t* rowp = U + (size_t)(tok0 - 128 + key) * INC; kv = *(const u32x4*)(rowp + 2048 + ch * 8); vv = *(const u32x4*)(rowp + 2176 + ch * 8); }
        *(LAS u32x4*)(lds + SW_KOFF + key * SW_KSTR + ch * 16) = kv;
        *(LAS u32x4*)(lds + SW_VOFF + key * SW_VSTR + ch * 16) = vv;
    }
    {
        const int c0 = lane * 8, t0 = tok0 + 8 * wid, s0 = q0s + 8 * wid;
        float w0[8], w1[8], w2[8], p2[8], p1[8];
#pragma unroll
        for (int e = 0; e < 8; ++e) { w0[e] = convw[c0 + e]; w1[e] = convw[512 + c0 + e]; w2[e] = convw[1024 + c0 + e]; p2[e] = 0.f; p1[e] = 0.f; }
        if (s0 >= 2) {
            const bf16_t* r2 = U + (size_t)(t0 - 2) * INC; const bf16_t* r1 = U + (size_t)(t0 - 1) * INC;
            const u32x4 gc2 = *(const u32x4*)(r2 + 512 + c0), xc2 = *(const u32x4*)(r2 + 1024 + c0), gc1 = *(const u32x4*)(r1 + 512 + c0), xc1 = *(const u32x4*)(r1 + 1024 + c0);
#pragma unroll
            for (int e = 0; e < 4; ++e) { p2[2 * e] = bf_lo(gc2[e]) * bf_lo(xc2[e]); p2[2 * e + 1] = bf_hi(gc2[e]) * bf_hi(xc2[e]); p1[2 * e] = bf_lo(gc1[e]) * bf_lo(xc1[e]); p1[2 * e + 1] = bf_hi(gc1[e]) * bf_hi(xc1[e]); }
        }
#pragma unroll 2
        for (int j = 0; j < 8; ++j) {
            const bf16_t* r = U + (size_t)(t0 + j) * INC;
            const u32x4 gb = *(const u32x4*)(r + c0), gc = *(const u32x4*)(r + 512 + c0), xc = *(const u32x4*)(r + 1024 + c0);
            float pc[8], o[8]; float ss = 0.f;
#pragma unroll
            for (int e = 0; e < 4; ++e) { pc[2 * e] = bf_lo(gc[e]) * bf_lo(xc[e]); pc[2 * e + 1] = bf_hi(gc[e]) * bf_hi(xc[e]); }
#pragma unroll
            for (int e = 0; e < 8; ++e) {
                const float cv = w0[e] * p2[e] + w1[e] * p1[e] + w2[e] * pc[e];
                const float gbv = (e & 1) ? bf_hi(gb[e >> 1]) : bf_lo(gb[e >> 1]);
                o[e] = gbv * cv; ss += o[e] * o[e];
            }
            ss = wave_sum(ss);
            const float rs = 1.0f / sqrtf(ss * (1.0f / 512.0f) + EPS);
            u32x4 w; w.x = pk2(o[0] * rs, o[1] * rs); w.y = pk2(o[2] * rs, o[3] * rs); w.z = pk2(o[4] * rs, o[5] * rs); w.w = pk2(o[6] * rs, o[7] * rs);
            *(u32x4*)(MIX + (size_t)(t0 + j) * D + c0) = w;
#pragma unroll
            for (int e = 0; e < 8; ++e) { p2[e] = p1[e]; p1[e] = pc[e]; }
        }
    }
    const int h = wid, kvh = h >> 2, r32 = lane & 31, hi = lane >> 5;
    const float sink2 = sinks[h] * LOG2E;
    __syncthreads();
    LAS float* X = (LAS float*)(lds + SW_XOFF);
    const int qq = (lane & 15) >> 2, pp = lane & 3, gg = (lane >> 4) & 1;
#pragma unroll 1
    for (int qs = 0; qs < 2; ++qs) {
        bf16x8 qf[4];
#pragma unroll
        for (int kb = 0; kb < 4; ++kb) qf[kb] = *(const bf16x8*)(U + (size_t)(tok0 + 32 * qs + r32) * INC + 1536 + h * 64 + 16 * kb + 8 * hi);
        f32x16 st[5];
#pragma unroll
        for (int kt = 0; kt < 5; ++kt) {
#pragma unroll
            for (int r = 0; r < 16; ++r) st[kt][r] = 0.f;
#pragma unroll
            for (int kb = 0; kb < 4; ++kb) {
                const bf16x8 kf = *(const LAS bf16x8*)(lds + SW_KOFF + (32 * (qs + kt) + r32) * SW_KSTR + (kvh * 64 + 16 * kb + 8 * hi) * 2);
                st[kt] = __builtin_amdgcn_mfma_f32_32x32x16_bf16(kf, qf[kb], st[kt], 0, 0, 0);
            }
        }
        float mx = sink2;
        const int kpos0 = q0s + 32 * qs - 128;
#pragma unroll
        for (int kt = 0; kt < 5; ++kt)
#pragma unroll
            for (int r = 0; r < 16; ++r) {
                const int kr = 32 * kt + crow(r, hi);
                const bool valid = (kr > r32) && (kr <= r32 + 128) && (kpos0 + kr >= 0);
                const float v = valid ? st[kt][r] : -INFINITY;
                st[kt][r] = v; mx = fmaxf(mx, v);
            }
        mx = fmaxf(mx, __shfl_xor(mx, 32));
        float sum = 0.f;
#pragma unroll
        for (int kt = 0; kt < 5; ++kt)
#pragma unroll
            for (int r = 0; r < 16; ++r) { const float p = __builtin_amdgcn_exp2f(st[kt][r] - mx); st[kt][r] = p; sum += p; }
        sum += __shfl_xor(sum, 32);
        sum += __builtin_amdgcn_exp2f(sink2 - mx);
        const float inv = 1.0f / sum;
        f32x16 o[2];
#pragma unroll
        for (int r = 0; r < 16; ++r) { o[0][r] = 0.f; o[1][r] = 0.f; }
#pragma unroll
        for (int kt = 0; kt < 5; ++kt)
#pragma unroll
            for (int s = 0; s < 2; ++s) {
                u32x4 pw; pw.x = pk2(st[kt][8 * s + 0], st[kt][8 * s + 1]); pw.y = pk2(st[kt][8 * s + 2], st[kt][8 * s + 3]); pw.z = pk2(st[kt][8 * s + 4], st[kt][8 * s + 5]); pw.w = pk2(st[kt][8 * s + 6], st[kt][8 * s + 7]);
                const bf16x8 pf = __builtin_bit_cast(bf16x8, pw);
#pragma unroll
                for (int dt = 0; dt < 2; ++dt) {
                    LAS unsigned char* vb = lds + SW_VOFF + (32 * (qs + kt) + 16 * s + 4 * hi + qq) * SW_VSTR + (kvh * 64 + 32 * dt + 16 * gg) * 2 + 8 * pp;
                    const s16x4 lo = vtr(vb), hi4 = vtr(vb + 8 * SW_VSTR);
                    const bf16x8 vf = __builtin_shufflevector(lo, hi4, 0, 1, 2, 3, 4, 5, 6, 7);
                    o[dt] = __builtin_amdgcn_mfma_f32_32x32x16_bf16(vf, pf, o[dt], 0, 0, 0);
                }
            }
        float ss = 0.f;
#pragma unroll
        for (int dt = 0; dt < 2; ++dt)
#pragma unroll
            for (int r = 0; r < 16; ++r) { o[dt][r] *= inv; ss += o[dt][r] * o[dt][r]; }
        ss += __shfl_xor(ss, 32);
        if (hi == 0) X[(qs * 32 + r32) * 8 + h] = ss;
        __syncthreads();
        const f32x4 xa = *(const LAS f32x4*)(X + (qs * 32 + r32) * 8), xb4 = *(const LAS f32x4*)(X + (qs * 32 + r32) * 8 + 4);
        const float tot = ((xa[0] + xa[1]) + (xa[2] + xa[3])) + ((xb4[0] + xb4[1]) + (xb4[2] + xb4[3]));
        const float rs = 1.0f / sqrtf(tot * (1.0f / 512.0f) + EPS);
        bf16_t* orow = MIX + (size_t)(tok0 + 32 * qs + r32) * D + 512 + h * 64 + 4 * hi;
#pragma unroll
        for (int dt = 0; dt < 2; ++dt)
#pragma unroll
            for (int g4 = 0; g4 < 4; ++g4) {
                u32x2 w; w.x = pk2(o[dt][4 * g4 + 0] * rs, o[dt][4 * g4 + 1] * rs); w.y = pk2(o[dt][4 * g4 + 2] * rs, o[dt][4 * g4 + 3] * rs);
                *(u32x2*)(orow + 32 * dt + 8 * g4) = w;
            }
    }
    __syncthreads();
}

#define XB_TMO      128
#define XB_XCNT(j)  (256  + 64 * (j))
#define XB_XSUB(j)  (1280 + 64 * (j))
#define XB_XGEN(j)  (2304 + 64 * (j))
#define XB_TOP      3328
#define XB_TOPGEN   3392
#define XCD_BAR_WORDS 3456
#define XB_SPIN_CAP (1u << 18)
DI unsigned xb_ld(unsigned* p)              { return __hip_atomic_load(p, __ATOMIC_RELAXED, __HIP_MEMORY_SCOPE_AGENT); }
DI unsigned xb_add(unsigned* p, unsigned v) { return __hip_atomic_fetch_add(p, v, __ATOMIC_RELAXED, __HIP_MEMORY_SCOPE_AGENT); }
DI unsigned xb_xcc_id() { return (unsigned)__builtin_amdgcn_s_getreg((3 << 11) | 20) & 0xFu; }
#define XB_SPIN(cond, bar) do { unsigned _sp = 0; while (cond) { __builtin_amdgcn_s_sleep(1); \
    if ((++_sp & 255u) == 0u) { if (xb_ld(&(bar)[XB_TMO])) break; if (_sp > XB_SPIN_CAP) { atomicAdd(&(bar)[XB_TMO], 1u); break; } } } } while (0)
struct XcdBarrier { unsigned* bar; unsigned x; volatile LAS unsigned* st; };
DI XcdBarrier xcd_barrier_post(unsigned* bar, volatile LAS unsigned* st) {
    XcdBarrier b; b.bar = bar; b.x = xb_xcc_id(); b.st = st;
    if (threadIdx.x == 0) st[4] = xb_add(&bar[XB_XCNT(b.x)], 1u);
    return b;
}
DI void team_barrier_at(unsigned* cnt, unsigned* bar, unsigned gen) {
    asm volatile("s_waitcnt vmcnt(0)" ::: "memory");
    __syncthreads();
    if (threadIdx.x == 0) {
        __builtin_amdgcn_s_waitcnt(0);
        (void)xb_add(cnt, 1u);
        const unsigned target = 4u * (gen + 1u);
        XB_SPIN(xb_ld(cnt) < target, bar);
        __builtin_amdgcn_fence(__ATOMIC_ACQUIRE, "agent");
        asm volatile("s_waitcnt vmcnt(0)" ::: "memory");
    }
    __syncthreads();
}
DI void team_barrier(unsigned* cnt, unsigned* bar, unsigned& gen) { team_barrier_at(cnt, bar, gen); ++gen; }
DI void guard_wait(unsigned* w, unsigned target, unsigned* bar) {
    if (threadIdx.x == 0) { XB_SPIN(xb_ld(w) < target, bar); }
    __syncthreads();
}
DI void xcd_barrier_complete(unsigned* bar, unsigned x, unsigned& nloc, unsigned& nx) {
    const unsigned G = gridDim.x * gridDim.y * gridDim.z;
    unsigned sum, cnt, mine, sp = 0u;
    for (;;) {
        sum = 0u; cnt = 0u; mine = 0u;
#pragma unroll
        for (unsigned j = 0; j < 16; ++j) { const unsigned c = xb_ld(&bar[XB_XCNT(j)]); sum += c; cnt += (c > 0u) ? 1u : 0u; mine = (j == x) ? c : mine; }
        if (sum == G) break;
        __builtin_amdgcn_s_sleep(1);
        if ((++sp & 255u) == 0u) { if (xb_ld(&bar[XB_TMO])) break; if (sp > XB_SPIN_CAP) { atomicAdd(&bar[XB_TMO], 1u); break; } }
    }
    nloc = mine > 0u ? mine : 1u; nx = cnt > 0u ? cnt : 1u;
}
DI void xcd_barrier(const XcdBarrier& b) {
    asm volatile("s_waitcnt vmcnt(0)" ::: "memory");
    __syncthreads();
    if (threadIdx.x == 0) {
        unsigned* bar = b.bar;
        __builtin_amdgcn_s_waitcnt(0);
        unsigned nloc = b.st[0], nx = b.st[1];
        if (nloc == 0u) { xcd_barrier_complete(bar, b.x, nloc, nx); b.st[0] = nloc; b.st[1] = nx; }
        const unsigned old = xb_add(&bar[XB_XSUB(b.x)], 1u);
        const unsigned gen = old / nloc;
        if (old + 1u == (gen + 1u) * nloc) {
            __builtin_amdgcn_fence(__ATOMIC_RELEASE, "agent");
            asm volatile("s_waitcnt vmcnt(0)" ::: "memory");
            const unsigned og = xb_add(&bar[XB_TOP], 1u);
            const unsigned tg = og / nx;
            if (og + 1u == (tg + 1u) * nx) xb_add(&bar[XB_TOPGEN], 1u);
            else XB_SPIN(xb_ld(&bar[XB_TOPGEN]) == tg, bar);
            __builtin_amdgcn_fence(__ATOMIC_ACQUIRE, "agent");
            xb_add(&bar[XB_XGEN(b.x)], 1u);
            asm volatile("s_waitcnt vmcnt(0)" ::: "memory");
        } else {
            XB_SPIN(xb_ld(&bar[XB_XGEN(b.x)]) == gen, bar);
            __builtin_amdgcn_fence(__ATOMIC_ACQUIRE, "agent");
            asm volatile("s_waitcnt vmcnt(0)" ::: "memory");
        }
    }
    __syncthreads();
}

DI int fill_rstd_table(const pg8::StaticOrder& S, const float* ssq, LAS unsigned char* scr) {
    pg8::Unit u0; const bool any = S.next(0, u0);
    int tid = threadIdx.x; asm volatile("" : "+v"(tid));
    if (any && tid < 256) ((LAS float*)(scr + 8192))[tid] = row_rstd(ssq, u0.pm * 256 + tid);
    __syncthreads();
    return any ? u0.pm : -1;
}

struct Args { const void* in[19]; float* out; unsigned char* ws; int ph_lo, ph_hi; };
constexpr int N_PHASES = 20;

__global__ void __launch_bounds__(512, 2) mk_fwd(Args args) {
    extern __shared__ __attribute__((aligned(16))) unsigned char lds_raw[];
    LAS unsigned char* lds = (LAS unsigned char*)lds_raw;
    LAS unsigned char* scr = lds + SCR_OFF;
    const int tid = threadIdx.x, lane = tid & 63, wid = __builtin_amdgcn_readfirstlane(tid >> 6);
    const int G = gridDim.x, bx = blockIdx.x;
    const int vcu = (G % 8 == 0) ? (bx % 8) * (G / 8) + bx / 8 : bx;
    const int gw = vcu * 8 + wid, NGW = G * 8;
    const int lo = args.ph_lo, hi = args.ph_hi;
#define IN(k) (lo <= (k) && (k) < hi)
#define SEAM(k) do { if (IN(k) && IN((k) + 1)) { xcd_barrier(bar); } } while (0)
#define TSEAM(k) do { if (IN(k) && IN((k) + 1)) { if (fast) team_barrier(tcnt, bar.bar, tgen); else xcd_barrier(bar); } } while (0)
    volatile LAS unsigned* MISC = (volatile LAS unsigned*)(lds + RING_BYTES);
    if (tid < 64) MISC[tid] = 0u;
    __syncthreads();
    XcdBarrier bar; bar.bar = (unsigned*)args.ws; bar.x = 0; bar.st = MISC + 8;
    if (hi - lo > 1) bar = xcd_barrier_post((unsigned*)args.ws, MISC + 8);

    const float* x_in = (const float*)args.in[0];
    const float* mem = (const float*)args.in[1];
    const int* positions = (const int*)args.in[2];
    const float* norm_mix_g = (const float*)args.in[3];
    const float* w_in = (const float*)args.in[4];
    const float* conv_w = (const float*)args.in[5];
    const float* sinks = (const float*)args.in[6];
    const float* gnorm_conv_g = (const float*)args.in[7];
    const float* gnorm_attn_g = (const float*)args.in[8];
    const float* w_out = (const float*)args.in[9];
    const float* norm_x_g = (const float*)args.in[10];
    const float* norm_mem_g = (const float*)args.in[11];
    const float* wx_q = (const float*)args.in[12];
    const float* wx_kv = (const float*)args.in[13];
    const float* wx_o = (const float*)args.in[14];
    const float* norm_mlp_g = (const float*)args.in[15];
    const float* w_up = (const float*)args.in[16];
    const float* w_down = (const float*)args.in[17];
    const float* final_g = (const float*)args.in[18];
    float* out = args.out;
    unsigned char* ws = args.ws;
    float* SSQ = (float*)(ws + WS_SSQ);
    bf16_t* XB = (bf16_t*)(ws + WS_XB);
    bf16_t* U = (bf16_t*)(ws + WS_U);
    bf16_t* MIX = (bf16_t*)(ws + WS_MIX);
    bf16_t* QX = (bf16_t*)out;
    bf16_t* PB = (bf16_t*)out;
    bf16_t* OX = (bf16_t*)out;
    bf16_t* HB = (bf16_t*)(ws + WS_H);
    bf16_t* MEMN = (bf16_t*)(ws + WS_MEMN);
    float* ROT = (float*)(ws + WS_ROT);
#define WPTR(l, off) ((bf16_t*)(ws + WS_W + (size_t)(l) * LW_STRIDE + (off)))
#define KVM(l) ((bf16_t*)(ws + WS_KMEM + (size_t)(l) * 4 * MiB))
    bf16_t* VPT = (bf16_t*)(ws + WS_VP);
    bf16_t* WPP = (bf16_t*)(ws + WS_VP + 8 * MiB);

        constexpr int I_IN = 16 * 72, I_SQ = 16 * 32, I_KV = 16 * 64, I_UP = 16 * 128, I_DN = 64 * 32;
        constexpr int I_LAYER = I_IN + I_SQ + I_KV + I_SQ + I_UP + I_DN;
        auto decode = [&](int it) -> TItem {
            const int l = it / I_LAYER; int r = it % I_LAYER;
            if (r < I_IN) return TItem{w_in + (size_t)l * D * INC, WPTR(l, LW_IN), norm_mix_g + l * D, nullptr, D, INC, 1536, 2176, r}; r -= I_IN;
            if (r < I_SQ) return TItem{w_out + (size_t)l * D * D, WPTR(l, LW_OUT), gnorm_conv_g + l * 512, gnorm_attn_g + l * 512, D, D, 0, 0, r}; r -= I_SQ;
            if (r < I_KV) return TItem{wx_kv + (size_t)l * D * 2 * D, WPTR(l, LW_KV), norm_mem_g + l * D, nullptr, D, 2 * D, 0, 0, r}; r -= I_KV;
            if (r < I_SQ) return TItem{wx_o + (size_t)l * D * D, WPTR(l, LW_O), nullptr, nullptr, D, D, 0, 0, r}; r -= I_SQ;
            if (r < I_UP) return TItem{w_up + (size_t)l * D * FF, WPTR(l, LW_UP), norm_mlp_g + l * D, nullptr, D, FF, 0, 0, r}; r -= I_UP;
            return TItem{w_down + (size_t)l * FF * D, WPTR(l, LW_DN), nullptr, nullptr, FF, D, 0, 0, r};
        };
    constexpr int NIF = 4;
    constexpr int O_OUT = I_IN, O_KV = O_OUT + I_SQ, O_O = O_KV + I_KV, O_UP = O_O + I_SQ, O_DN = O_UP + I_UP;
    constexpr int N_LATE = I_SQ + I_UP + I_UP, N_LATEB = I_DN, N_EARLY0 = I_LAYER - I_UP, N_EARLY = N_EARLY0 + I_IN + I_KV + I_SQ;
    auto early_it = [&](int e) -> int { const int e2 = e - N_EARLY0; return e < O_UP ? e : e < N_EARLY0 ? e + I_UP : e2 < I_IN ? I_LAYER + e2 : I_LAYER + O_KV + (e2 - I_IN); };
    auto late_it = [&](int j) -> int { return j < I_SQ ? I_LAYER + O_OUT + j : j < I_SQ + I_UP ? I_LAYER + O_UP + (j - I_SQ) : O_UP + (j - I_SQ - I_UP); };
    auto lateb_it = [&](int j) -> int { return I_LAYER + O_DN + j; };
    if (IN(0)) for (int rep = 0; rep < REP0; ++rep) {
        LAS float* tsc = (LAS float*)(lds + wid * 16384);
        {
            const int n_now = (G >= 256) ? N_EARLY : DEPTH * I_LAYER;
            for (int e = gw; e < n_now; e += NIF * NGW) {
                float v[NIF][32];
#pragma unroll
                for (int q = 0; q < NIF; ++q) { const int eq = e + q * NGW; if (eq < n_now) { const TItem t = decode(G >= 256 ? early_it(eq) : eq); p0_item_load(t, v[q], lane); } }
#pragma unroll
                for (int q = 0; q < NIF; ++q) { const int eq = e + q * NGW; if (eq < n_now) { const TItem t = decode(G >= 256 ? early_it(eq) : eq); p0_item_finish(t, v[q], tsc, lane); } }
            }
        }
        constexpr int NROWS = T + MROWS + DEPTH * D;
        for (int m0 = gw; m0 < NROWS; m0 += 2 * NGW) {
            f32x4 v[2][4];
#pragma unroll
            for (int q = 0; q < 2; ++q) {
                const int m = m0 + q * NGW;
                if (m < NROWS) {
                    const float* src = (m < T) ? x_in + (size_t)m * D : (m < T + MROWS) ? mem + (size_t)(m - T) * D : wx_q + (size_t)(m - T - MROWS) * D;
                    const f32x4* xr = (const f32x4*)src + lane;
#pragma unroll
                    for (int j = 0; j < 4; ++j) v[q][j] = __builtin_nontemporal_load(xr + 64 * j);
                }
            }
#pragma unroll
            for (int q = 0; q < 2; ++q) {
                const int m = m0 + q * NGW;
                if (m < NROWS) {
                    const bool isx = m < T, ismem = !isx && m < T + MROWS; const int row = isx ? m : ismem ? m - T : m - T - MROWS;
                    float rs = 1.0f;
                    if (isx || ismem) {
                        float s = 0.f;
#pragma unroll
                        for (int j = 0; j < 4; ++j) s += (v[q][j][0] * v[q][j][0] + v[q][j][1] * v[q][j][1]) + (v[q][j][2] * v[q][j][2] + v[q][j][3] * v[q][j][3]);
                        s = wave_sum(s);
                        if (ismem) rs = 1.0f / sqrtf(s * (1.0f / 1024.0f) + EPS);
                        else if (lane < 16) SSQ[(size_t)row * 16 + lane] = (lane == 0) ? s : 0.f;
                    } else rs = norm_x_g[row];
                    bf16_t* dst = isx ? XB + (size_t)row * D : ismem ? MEMN + (size_t)row * D : WPTR(row >> 10, LW_Q) + (size_t)(row & 1023) * D;
                    u32x2* o8 = (u32x2*)dst + lane;
#pragma unroll
                    for (int j = 0; j < 4; ++j) { u32x2 w; w.x = pk2(v[q][j][0] * rs, v[q][j][1] * rs); w.y = pk2(v[q][j][2] * rs, v[q][j][3] * rs); o8[64 * j] = w; }
                }
            }
        }
        for (int idx = (vcu * 512 + tid); idx < T * 32; idx += G * 512) {
            const int tok = idx >> 5, i = idx & 31;
            double f = 1.0; for (int k = 0; k < i; ++k) f *= 0.74989420933245582730;
            const float inv = (float)f;
            const float ang = (float)positions[tok] * inv;
            double rev = (double)ang * 0.15915494309189533577; rev -= __builtin_rint(rev);
            const float rv = (float)rev;
            f32x2 cs = {__builtin_amdgcn_cosf(rv), __builtin_amdgcn_sinf(rv)};
            *(f32x2*)(ROT + (size_t)idx * 2) = cs;
        }
    }
    SEAM(0);
    if (tid == 0) {
        unsigned fastv = 0u, xv = (unsigned)bx % 8u, offv = (unsigned)bx / 8u;
        if (hi - lo > 1 && G == 256) {
            unsigned npop = 0u, ok = 1u, below = 0u;
#pragma unroll
            for (unsigned j = 0; j < 16; ++j) { const unsigned c = xb_ld(&bar.bar[XB_XCNT(j)]); if (c) { ++npop; if (c != 32u) ok = 0u; if (j < bar.x) ++below; } }
            if (FORCE_FALLBACK == 0 && ok && npop == 8u && xb_ld(&bar.bar[XB_TMO]) == 0u) { fastv = 1u; xv = below; offv = MISC[12]; }
        }
        MISC[16] = fastv; MISC[17] = xv; MISC[18] = offv;
    }
    __syncthreads();
    const bool fast = MISC[16] != 0u;
    const int vx = (int)MISC[17], voff = (int)MISC[18];
    const int cc = (G % 8 == 0) ? voff * 8 + vx : bx;
    unsigned* tcnt = (unsigned*)args.ws + 4096 + (vx * 8 + (voff & 7)) * 64;
    unsigned tgen = 0u;
    unsigned* war3 = (unsigned*)args.ws + 8192; unsigned* war6 = (unsigned*)args.ws + 8192 + 64; unsigned* war8 = (unsigned*)args.ws + 8192 + 128; unsigned* war5 = (unsigned*)args.ws + 8192 + 192;

#pragma unroll 1
    for (int l = 0; l < DEPTH; ++l) {
        const int pb = 1 + 9 * l;
        if (IN(pb + 0)) for (int rep = 0; rep < REP1; ++rep) {
            { pg8::Gemm g = pg8::std_gemm(XB, WPTR(l, LW_IN), D, D, D, T / 256, INC / 256); pg8::StaticOrder S; S.init(T / 256, INC / 256, G, cc);
              pg8::EpiWin E{U, SSQ, ROT, fill_rstd_table(S, SSQ, scr), (fast && l > 0) ? war8 : nullptr, (unsigned)G * (unsigned)l, bar.bar}; pg8::gemm_phase(lds, scr, g, S, E); }
            if (l == 0) {
#pragma unroll 1
                for (int j = 0; j < 2; ++j) {
                    pg8::Gemm g = pg8::std_gemm(MEMN, WPTR(j, LW_KV), D, D, D, 4, 8); pg8::StaticOrder S; S.init(4, 8, G, (cc + 4 * G - 64 - 32 * j) % G);
                    pg8::EpiScale<0> E{KVM(j), 2 * D, nullptr, 1.0f}; pg8::gemm_phase(lds, scr, g, S, E);
                }
                if (G >= 256 && cc >= 128) {
                    int tid2 = threadIdx.x; asm volatile("" : "+v"(tid2));
                    const int lane2 = tid2 & 63, wid2 = __builtin_amdgcn_readfirstlane(tid2 >> 6);
                    LAS float* tsc2 = (LAS float*)(lds + wid2 * 16384);
                    const int lw = (cc - 128) * 8 + wid2, NLW = (G - 128) * 8;
#pragma unroll 1
                    for (int j0 = lw; j0 < N_LATE; j0 += NLW) {
                        float v[32];
                        const TItem t = decode(late_it(j0));
                        p0_item_load(t, v, lane2);
                        p0_item_finish(t, v, tsc2, lane2);
                    }
                    __syncthreads();
                }
            } else {
                if (fast) guard_wait(war6, (unsigned)G * (unsigned)l, bar.bar);
                { pg8::Gemm g{WPTR(l, LW_O), KVM(l) + D, 256, D, 2 * D, 16, 4, 4, 0, 256L * D, 256, 4, 256L * 2 * D, 0, 256}; pg8::StaticOrder S; S.init(16, 4, G, (cc + 4 * G - 64) % G);
                  pg8::EpiScale<0> E{VPT, D, nullptr, 1.0f}; pg8::gemm_phase(lds, scr, g, S, E); }
                if (fast) guard_wait(war5, (unsigned)G * (unsigned)l, bar.bar);
                { pg8::Gemm g{KVM(l), WPTR(l, LW_Q), 256, 2 * D, D, 16, 4, 4, 256L * 2 * D, 256, 0, 4, 0, 256, 256L * D}; pg8::StaticOrder S; S.init(16, 4, G, (cc + 4 * G - 128) % G);
                  pg8::EpiScale<0> E{WPP, D, nullptr, 1.0f}; pg8::gemm_phase(lds, scr, g, S, E); }
                if (l == 1 && G >= 256 && cc >= 192) {
                    int tid2 = threadIdx.x; asm volatile("" : "+v"(tid2));
                    const int lane2 = tid2 & 63, wid2 = __builtin_amdgcn_readfirstlane(tid2 >> 6);
                    LAS float* tsc2 = (LAS float*)(lds + wid2 * 16384);
                    const int lw = (cc - 192) * 8 + wid2, NLW = (G - 192) * 8;
#pragma unroll 1
                    for (int j0 = lw; j0 < N_LATEB; j0 += NLW) {
                        float v[32];
                        const TItem t = decode(lateb_it(j0));
                        p0_item_load(t, v, lane2);
                        p0_item_finish(t, v, tsc2, lane2);
                    }
                    __syncthreads();
                }
            }
        }
        SEAM(pb + 0);
        if (IN(pb + 1)) for (int rep = 0; rep < REP2; ++rep) {
            const int unit0 = fast ? ((8 * vx + (voff & 7)) * 4 + (voff >> 3)) : vcu;
            for (int unit = unit0; unit < NB * 64; unit += G) swa_conv_unit(unit, U, MIX, conv_w + l * 3 * 512, sinks + l * 8, lds);
        }
        if (l == 0 && IN(pb + 1)) {
            { pg8::Gemm g{WPTR(0, LW_O), KVM(0) + D, 256, D, 2 * D, 16, 4, 4, 0, 256L * D, 256, 4, 256L * 2 * D, 0, 256}; pg8::StaticOrder S; S.init(16, 4, G, cc);
              pg8::EpiScale<0> E{VPT, D, nullptr, 1.0f}; pg8::gemm_phase(lds, scr, g, S, E); }
            { pg8::Gemm g{KVM(0), WPTR(0, LW_Q), 256, 2 * D, D, 16, 4, 4, 256L * 2 * D, 256, 0, 4, 0, 256, 256L * D}; pg8::StaticOrder S; S.init(16, 4, G, (cc + 4 * G - 64) % G);
              pg8::EpiScale<0> E{WPP, D, nullptr, 1.0f}; pg8::gemm_phase(lds, scr, g, S, E); }
        }
        if (l == 0) SEAM(pb + 1); else TSEAM(pb + 1);
        if (IN(pb + 2)) {
            pg8::Gemm g = pg8::std_gemm(MIX, WPTR(l, LW_OUT), D, D, D, T / 256, 4); pg8::StaticOrder S; S.init(T / 256, 4, G, cc);
            if (l == 0) { pg8::EpiResid<0> E{x_in, out, XB, SSQ}; pg8::gemm_phase(lds, scr, g, S, E); } else { pg8::EpiResid<1> E{x_in, out, XB, SSQ}; pg8::gemm_phase(lds, scr, g, S, E); }
        }
        TSEAM(pb + 2);
        if (fast && tid == 0) (void)xb_add(war3, 1u);
        if (IN(pb + 3)) for (int rep = 0; rep < REP4; ++rep) {
            pg8::Gemm g{XB, WPP, D, D, D, T / 256, 4, 1, 256L * D, 0, 0, 16, (long)D * D, 0, 256L * D}; pg8::StaticOrder S; S.init(T / 256, 4, G, cc);
            pg8::EpiSoftmax E{PB, D, SSQ, XSCALE, fill_rstd_table(S, SSQ, scr)}; pg8::gemm_phase(lds, scr, g, S, E);
        }
        if (fast && tid == 0) (void)xb_add(war5, 1u);
        TSEAM(pb + 4);
        if (IN(pb + 6)) {
            pg8::Gemm g{PB, VPT, D, D, D, T / 256, 4, 1, 256L * D, 0, 0, 16, (long)D * D, 0, 256L * D}; pg8::StaticOrder S; S.init(T / 256, 4, G, cc);
            pg8::EpiResid<1> E{x_in, out, XB, SSQ}; pg8::gemm_phase(lds, scr, g, S, E);
        }
        if (fast) { if (IN(pb + 6) && IN(pb + 7)) { team_barrier(tcnt, bar.bar, tgen); if (tid == 0) (void)xb_add(war6, 1u); guard_wait(war3, (unsigned)G * (unsigned)(l + 1), bar.bar); } }
        else SEAM(pb + 6);
        if (IN(pb + 7)) for (int rep = 0; rep < REP7; ++rep) {
            pg8::Gemm g = pg8::std_gemm(XB, WPTR(l, LW_UP), D, D, D, T / 256, FF / 256); pg8::StaticOrder S; S.init(T / 256, FF / 256, G, cc);
            pg8::EpiScale<1> E{HB, FF, SSQ, 1.0f, fill_rstd_table(S, SSQ, scr)}; pg8::gemm_phase(lds, scr, g, S, E);
        }
        TSEAM(pb + 7);
        if (IN(pb + 8)) {
            pg8::Gemm g = pg8::std_gemm(HB, WPTR(l, LW_DN), FF, FF, FF, T / 256, 4); pg8::StaticOrder S; S.init(T / 256, 4, G, cc);
            if (l == DEPTH - 1) {
                if (fast) guard_wait(war6, (unsigned)G * (unsigned)DEPTH, bar.bar);
                if (fast) { pg8::EpiFinal E{out, XB, SSQ, final_g, tcnt, bar.bar, tgen}; pg8::gemm_phase(lds, scr, g, S, E); ++tgen; }
                else { pg8::EpiResid<2> E{x_in, out, XB, SSQ}; pg8::gemm_phase(lds, scr, g, S, E); }
            } else { pg8::EpiResid<1> E{x_in, out, XB, SSQ}; pg8::gemm_phase(lds, scr, g, S, E); }
        }
        if (fast) {
            if (l < DEPTH - 1 && IN(pb + 8) && IN(pb + 9)) { if (tid == 0) (void)xb_add(war8, 1u); team_barrier(tcnt, bar.bar, tgen); }
        } else SEAM(pb + 8);
    }
    if (IN(19) && !fast) {
        for (int m = gw; m < T; m += NGW) {
            const float rs = row_rstd(SSQ, m);
            f32x4* xr = (f32x4*)(out + (size_t)m * D) + lane; const f32x4* gr = (const f32x4*)final_g + lane;
#pragma unroll
            for (int j = 0; j < 4; ++j) { const f32x4 v = xr[64 * j], gv = gr[64 * j]; xr[64 * j] = v * rs * gv; }
        }
    }
#undef IN
#undef SEAM
#undef TSEAM
}

extern "C" void kernel_launch(void* const* d_in, const int* in_sizes, int n_in, void* d_out, int out_size, void* d_ws, size_t ws_size, hipStream_t stream) {
    static int grid = 0;
    if (grid == 0) {
        if (n_in != 19 || in_sizes[0] != T * D || out_size != T * D || ws_size < WS_END) { fprintf(stderr, "kernel_launch: unexpected shapes (n_in %d, in0 %d, out %d, ws %zu)\n", n_in, n_in > 0 ? in_sizes[0] : -1, out_size, ws_size); grid = -1; return; }
        int dev = 0, cus = 0, per_cu = 0;
        if (hipGetDevice(&dev) != hipSuccess || hipDeviceGetAttribute(&cus, hipDeviceAttributeMultiprocessorCount, dev) != hipSuccess) { grid = -1; return; }
        if (hipFuncSetAttribute((const void*)mk_fwd, hipFuncAttributeMaxDynamicSharedMemorySize, LDS_BYTES) != hipSuccess) { fprintf(stderr, "kernel_launch: hipFuncSetAttribute failed\n"); grid = -1; return; }
        if (hipOccupancyMaxActiveBlocksPerMultiprocessor(&per_cu, (const void*)mk_fwd, 512, LDS_BYTES) != hipSuccess || per_cu < 1) { fprintf(stderr, "kernel_launch: occupancy query failed (%d)\n", per_cu); (void)hipGetLastError(); grid = -1; return; }
        grid = cus * per_cu;
    }
    if (grid < 0) return;
    Args a{};
    for (int i = 0; i < 19; ++i) a.in[i] = d_in[i];
    a.out = (float*)d_out; a.ws = (unsigned char*)d_ws;
    if (hipMemsetAsync(d_ws, 0, 65536, stream) != hipSuccess) { fprintf(stderr, "kernel_launch: memset of barrier words failed\n"); return; }
#if MK_MULTI
    for (int p = 0; p < N_PHASES; ++p) {
        a.ph_lo = p; a.ph_hi = p + 1;
        hipLaunchKernelGGL(mk_fwd, dim3(grid), dim3(512), LDS_BYTES, stream, a);
    }
#else
    a.ph_lo = 0; a.ph_hi = N_PHASES;
    void* kargs[] = {&a};
    hipError_t e = hipLaunchCooperativeKernel((const void*)mk_fwd, dim3(grid), dim3(512), kargs, LDS_BYTES, stream);
    if (e != hipSuccess) fprintf(stderr, "cooperative launch failed: %s (grid %d)\n", hipGetErrorString(e), grid);
#endif
}
```

```cpp
#include <hip/hip_runtime.h>
#include <hip/hip_cooperative_groups.h>
#include <cstdio>
#include <cstdint>
namespace cg = cooperative_groups;

#ifndef REP0
#define REP0 1
#endif
#ifndef REP1
#define REP1 1
#endif
#ifndef REP2
#define REP2 1
#endif
#ifndef REP4
#define REP4 1
#endif
#ifndef REP5
#define REP5 1
#endif
#ifndef REP7
#define REP7 1
#endif
#ifndef FORCE_FALLBACK
#define FORCE_FALLBACK 0
#endif
#ifndef MK_MULTI
#define MK_MULTI 0
#endif

#define DI __device__ __forceinline__
#define LAS __attribute__((address_space(3)))
typedef unsigned short bf16_t;
typedef short bf16x8 __attribute__((ext_vector_type(8)));
typedef short s16x4 __attribute__((ext_vector_type(4)));
typedef float f32x2 __attribute__((ext_vector_type(2)));
typedef float f32x4 __attribute__((ext_vector_type(4)));
typedef float f32x16 __attribute__((ext_vector_type(16)));
typedef unsigned u32x2 __attribute__((ext_vector_type(2)));
typedef unsigned u32x4 __attribute__((ext_vector_type(4)));
typedef __bf16 bf16x2_t __attribute__((ext_vector_type(2)));

constexpr int NB = 4, SEQ = 4096, T = NB * SEQ, D = 1024, NMEM = 256, MROWS = NB * NMEM, INC = 2304, FF = 4096, DEPTH = 2;
constexpr float EPS = 1e-6f, LOG2E = 1.4426950408889634f;
constexpr float QSCALE = 0.125f * LOG2E;
constexpr float XSCALE = 0.0625f * LOG2E;

constexpr size_t MiB = 1u << 20;
constexpr size_t WS_SSQ = 1 * MiB;
constexpr size_t WS_W = 2 * MiB;
constexpr size_t LW_IN = 0, LW_OUT = 9 * MiB / 2, LW_Q = 13 * MiB / 2, LW_KV = 17 * MiB / 2, LW_O = 25 * MiB / 2, LW_UP = 29 * MiB / 2, LW_DN = 45 * MiB / 2, LW_STRIDE = 61 * MiB / 2;
constexpr size_t WS_XB = 64 * MiB;
constexpr size_t WS_U = 96 * MiB;
constexpr size_t WS_MIX = 168 * MiB;
constexpr size_t WS_QX = 96 * MiB, WS_P = 128 * MiB, WS_OX = 168 * MiB;
constexpr size_t WS_H = 96 * MiB;
constexpr size_t WS_KMEM = 224 * MiB;
constexpr size_t WS_VT = 228 * MiB;
constexpr size_t WS_MEMN = 232 * MiB;
constexpr size_t WS_ROT = 234 * MiB;
constexpr size_t WS_VP = 238 * MiB;
constexpr size_t WS_END = 254 * MiB;

constexpr int RING_BYTES = 131072, SCR_OFF = RING_BYTES + 1024, LDS_BYTES = 147456;

DI unsigned pk2(float lo, float hi) { f32x2 v = {lo, hi}; bf16x2_t b = __builtin_convertvector(v, bf16x2_t); return __builtin_bit_cast(unsigned, b); }
DI float bf_lo(unsigned w) { return __uint_as_float(w << 16); }
DI float bf_hi(unsigned w) { return __uint_as_float(w & 0xffff0000u); }
DI float row_rstd(const float* ssq, int row) {
    const f32x4* p = (const f32x4*)(ssq + (size_t)row * 16);
    const f32x4 a = p[0], b = p[1], c = p[2], d = p[3];
    const float s = ((a[0] + a[1]) + (a[2] + a[3])) + ((b[0] + b[1]) + (b[2] + b[3])) + ((c[0] + c[1]) + (c[2] + c[3])) + ((d[0] + d[1]) + (d[2] + d[3]));
    return 1.0f / sqrtf(s * (1.0f / 1024.0f) + EPS);
}

DI void team_barrier_at(unsigned* cnt, unsigned* bar, unsigned gen);

namespace pg8 {
constexpr int BM = 256, BK = 64, HALF = 128, HTB = HALF * BK * 2, NXCD = 8, WGM = 8;
__host__ __device__ __forceinline__ int lds_byte(int r, int c) { const int st = (r >> 4) * 2 + (c >> 5), rr = r & 15, cc = c & 31, ob = rr * 64 + cc * 2; return st * 1024 + (ob ^ (((ob >> 9) & 1) << 5)); }
__host__ __device__ __forceinline__ void stage_rc(int b, int& R, int& C) { const int st = b / 1024, sb = b % 1024, swz = sb ^ (((sb >> 9) & 1) << 5); R = (st >> 1) * 16 + swz / 64; C = (st & 1) * 32 + (swz % 64) / 2; }
__host__ __device__ __forceinline__ int perm32(int rho) { const int n = rho >> 4, i = rho & 15; return 8 * (i >> 2) + 4 * n + (i & 3); }

struct Unit { int pm, pn; };
struct Gemm { const bf16_t* A; const bf16_t* Bt; int K, lda, ldb, nM, nN; int a_div; long a_s1, a_s2, a_s3; int b_div; long b_s1, b_s2, b_s3; };
DI Gemm std_gemm(const bf16_t* A, const bf16_t* Bt, int K, int lda, int ldb, int nM, int nN) { return Gemm{A, Bt, K, lda, ldb, nM, nN, 1, 256L * lda, 0, 0, 1, 0, 0, 256L * ldb}; }
DI const char* abase(const Gemm& g, const Unit& u) { return (const char*)(g.A + (size_t)(u.pm / g.a_div) * g.a_s1 + (size_t)(u.pm % g.a_div) * g.a_s2 + (size_t)u.pn * g.a_s3); }
DI const char* bbase(const Gemm& g, const Unit& u) { return (const char*)(g.Bt + (size_t)(u.pm / g.b_div) * g.b_s1 + (size_t)(u.pm % g.b_div) * g.b_s2 + (size_t)u.pn * g.b_s3); }

struct StaticOrder {
    int nM, nN, nwg, G, c;
    DI void init(int nM_, int nN_, int G_, int c_) { nM = nM_; nN = nN_; nwg = nM * nN; G = G_; c = c_; }
    DI bool next(int i, Unit& u) const {
        const long L = (long)i * G + c; if (L >= nwg) return false;
        int wgid = (int)L; { const int q = nwg / NXCD, r = nwg % NXCD, xcd = wgid % NXCD, off = wgid / NXCD; wgid = (xcd < r ? xcd * (q + 1) : r * (q + 1) + (xcd - r) * q) + off; }
        const int nig = WGM * nN, gid = wgid / nig, fm = gid * WGM, gsz = (nM - fm) < WGM ? (nM - fm) : WGM;
        u.pm = fm + ((wgid % nig) % gsz); u.pn = (wgid % nig) / gsz; return true;
    }
};

typedef f32x4 Acc[2][2][4][2];

template <int ACT> struct EpiScale {
    static constexpr bool PERM = true;
    bf16_t* O; int ldc; const float* ssq; float scale; int pm0 = -1;
    DI void operator()(Acc& acc, const Unit& u, int wr, int wc, int fr, int fq, LAS unsigned char* scr) const {
        const int row0 = u.pm * BM + wr * 64 + fr, col0 = u.pn * BM + wc * 32 + 8 * fq;
        const LAS float* tab = (const LAS float*)(scr + 8192);
#pragma unroll
        for (int ai = 0; ai < 2; ++ai)
#pragma unroll
            for (int m = 0; m < 4; ++m) {
                const int row = row0 + ai * HALF + m * 16;
                const float rs = ssq ? ((u.pm == pm0) ? tab[ai * HALF + wr * 64 + m * 16 + fr] : row_rstd(ssq, row)) * scale : scale;
                bf16_t* rowp = O + (size_t)row * ldc + col0;
#pragma unroll
                for (int bj = 0; bj < 2; ++bj) {
                    f32x4 v0 = acc[ai][bj][m][0] * rs, v1 = acc[ai][bj][m][1] * rs;
                    if (ACT == 1) {
#pragma unroll
                        for (int e = 0; e < 4; ++e) { const float a = fmaxf(v0[e], 0.f), b = fmaxf(v1[e], 0.f); v0[e] = a * a; v1[e] = b * b; }
                    }
                    u32x4 w; w.x = pk2(v0[0], v0[1]); w.y = pk2(v0[2], v0[3]); w.z = pk2(v1[0], v1[1]); w.w = pk2(v1[2], v1[3]);
                    *(u32x4*)(rowp + bj * HALF) = w;
                }
            }
    }
};

struct EpiWin {
    static constexpr bool PERM = true;
    bf16_t* U; const float* ssq; const float* rot; int pm0 = -1; unsigned* war = nullptr; unsigned war_target = 0u; unsigned* barw = nullptr;
    DI void operator()(Acc& acc, const Unit& u, int wr, int wc, int fr, int fq, LAS unsigned char* scr) const {
        const LAS float* tab = (const LAS float*)(scr + 8192);
        if (war) {
            unsigned sp = 0u;
            while (__hip_atomic_load(war, __ATOMIC_RELAXED, __HIP_MEMORY_SCOPE_AGENT) < war_target) {
                __builtin_amdgcn_s_sleep(1);
                if ((++sp & 255u) == 0u) { if (__hip_atomic_load(barw + 128, __ATOMIC_RELAXED, __HIP_MEMORY_SCOPE_AGENT)) break; if (sp > (1u << 18)) { atomicAdd(barw + 128, 1u); break; } }
            }
        }
        const int row0 = u.pm * BM + wr * 64 + fr, col0 = u.pn * BM + wc * 32 + 8 * fq;
        const bool isq = (u.pn == 6) || (u.pn == 7), isk8 = (u.pn == 8);
        const int i0 = 16 * (wc & 1) + 4 * fq;
#pragma unroll
        for (int ai = 0; ai < 2; ++ai)
#pragma unroll
            for (int m = 0; m < 4; ++m) {
                const int row = row0 + ai * HALF + m * 16;
                const float rs = (u.pm == pm0) ? tab[ai * HALF + wr * 64 + m * 16 + fr] : row_rstd(ssq, row);
                bf16_t* rowp = U + (size_t)row * INC + col0;
                f32x4 cs0 = {1.f, 0.f, 1.f, 0.f}, cs1 = {1.f, 0.f, 1.f, 0.f};
                if (isq || isk8) { const f32x4* rp = (const f32x4*)(rot + ((size_t)row * 32 + i0) * 2); cs0 = rp[0]; cs1 = rp[1]; }
#pragma unroll
                for (int bj = 0; bj < 2; ++bj) {
                    f32x4 v0 = acc[ai][bj][m][0] * rs, v1 = acc[ai][bj][m][1] * rs;
                    if (isq || (isk8 && bj == 0)) {
                        const float sc = isq ? QSCALE : 1.0f;
                        f32x4 r0, r1;
                        r0[0] = (v0[0] * cs0[0] - v0[1] * cs0[1]) * sc; r0[1] = (v0[1] * cs0[0] + v0[0] * cs0[1]) * sc;
                        r0[2] = (v0[2] * cs0[2] - v0[3] * cs0[3]) * sc; r0[3] = (v0[3] * cs0[2] + v0[2] * cs0[3]) * sc;
                        r1[0] = (v1[0] * cs1[0] - v1[1] * cs1[1]) * sc; r1[1] = (v1[1] * cs1[0] + v1[0] * cs1[1]) * sc;
                        r1[2] = (v1[2] * cs1[2] - v1[3] * cs1[3]) * sc; r1[3] = (v1[3] * cs1[2] + v1[2] * cs1[3]) * sc;
                        v0 = r0; v1 = r1;
                    }
                    u32x4 w; w.x = pk2(v0[0], v0[1]); w.y = pk2(v0[2], v0[3]); w.z = pk2(v1[0], v1[1]); w.w = pk2(v1[2], v1[3]);
                    *(u32x4*)(rowp + bj * HALF) = w;
                }
            }
    }
};

template <int MODE> struct EpiResid {
    static constexpr bool PERM = true;
    const float* basef; float* out; bf16_t* xb; float* ssq;
    DI void operator()(Acc& acc, const Unit& u, int wr, int wc, int fr, int fq, LAS unsigned char*) const {
        const int row0 = u.pm * BM + wr * 64 + fr, col0 = u.pn * BM + wc * 32 + 8 * fq;
#pragma unroll
        for (int ai = 0; ai < 2; ++ai)
#pragma unroll
            for (int m = 0; m < 4; ++m) {
                const int row = row0 + ai * HALF + m * 16; const size_t off = (size_t)row * D + col0;
                float s = 0.f;
#pragma unroll
                for (int bj = 0; bj < 2; ++bj) {
                    f32x4 b0, b1;
                    if (MODE == 0) { b0 = __builtin_nontemporal_load((const f32x4*)(basef + off + bj * HALF)); b1 = __builtin_nontemporal_load((const f32x4*)(basef + off + bj * HALF + 4)); }
                    else { const u32x4 w = *(const u32x4*)(xb + off + bj * HALF); b0 = (f32x4){bf_lo(w.x), bf_hi(w.x), bf_lo(w.y), bf_hi(w.y)}; b1 = (f32x4){bf_lo(w.z), bf_hi(w.z), bf_lo(w.w), bf_hi(w.w)}; }
                    const f32x4 o0 = b0 + acc[ai][bj][m][0], o1 = b1 + acc[ai][bj][m][1];
                    if (MODE == 2) {
                        *(f32x4*)(out + off + bj * HALF) = o0; *(f32x4*)(out + off + bj * HALF + 4) = o1;
                        s += ((o0[0] * o0[0] + o0[1] * o0[1]) + (o0[2] * o0[2] + o0[3] * o0[3])) + ((o1[0] * o1[0] + o1[1] * o1[1]) + (o1[2] * o1[2] + o1[3] * o1[3]));
                    } else {
                        u32x4 w; w.x = pk2(o0[0], o0[1]); w.y = pk2(o0[2], o0[3]); w.z = pk2(o1[0], o1[1]); w.w = pk2(o1[2], o1[3]);
                        *(u32x4*)(xb + off + bj * HALF) = w;
                        const float r0 = bf_lo(w.x), r1 = bf_hi(w.x), r2 = bf_lo(w.y), r3 = bf_hi(w.y), r4 = bf_lo(w.z), r5 = bf_hi(w.z), r6 = bf_lo(w.w), r7 = bf_hi(w.w);
                        s += ((r0 * r0 + r1 * r1) + (r2 * r2 + r3 * r3)) + ((r4 * r4 + r5 * r5) + (r6 * r6 + r7 * r7));
                    }
                }
                s += __shfl_xor(s, 16); s += __shfl_xor(s, 32);
                if (fq == 0) ssq[(size_t)row * 16 + u.pn * 4 + wc] = s;
            }
    }
};

struct EpiFinal {
    static constexpr bool PERM = true;
    float* out; const bf16_t* xb; float* ssq; const float* fg; unsigned* tcnt; unsigned* barw; unsigned gen;
    DI void operator()(Acc& acc, const Unit& u, int wr, int wc, int fr, int fq, LAS unsigned char*) const {
        const int row0 = u.pm * BM + wr * 64 + fr, col0 = u.pn * BM + wc * 32 + 8 * fq;
#pragma unroll
        for (int ai = 0; ai < 2; ++ai)
#pragma unroll
            for (int m = 0; m < 4; ++m) {
                const int row = row0 + ai * HALF + m * 16; const size_t off = (size_t)row * D + col0;
                float s = 0.f;
#pragma unroll
                for (int bj = 0; bj < 2; ++bj) {
                    const u32x4 w = *(const u32x4*)(xb + off + bj * HALF);
                    const f32x4 o0 = (f32x4){bf_lo(w.x), bf_hi(w.x), bf_lo(w.y), bf_hi(w.y)} + acc[ai][bj][m][0], o1 = (f32x4){bf_lo(w.z), bf_hi(w.z), bf_lo(w.w), bf_hi(w.w)} + acc[ai][bj][m][1];
                    acc[ai][bj][m][0] = o0; acc[ai][bj][m][1] = o1;
                    s += ((o0[0] * o0[0] + o0[1] * o0[1]) + (o0[2] * o0[2] + o0[3] * o0[3])) + ((o1[0] * o1[0] + o1[1] * o1[1]) + (o1[2] * o1[2] + o1[3] * o1[3]));
                }
                s += __shfl_xor(s, 16); s += __shfl_xor(s, 32);
                if (fq == 0) ssq[(size_t)row * 16 + u.pn * 4 + wc] = s;
            }
        team_barrier_at(tcnt, barw, gen);
        f32x4 gv[2][2];
#pragma unroll
        for (int bj = 0; bj < 2; ++bj) { gv[bj][0] = *(const f32x4*)(fg + col0 + bj * HALF); gv[bj][1] = *(const f32x4*)(fg + col0 + bj * HALF + 4); }
#pragma unroll
        for (int ai = 0; ai < 2; ++ai)
#pragma unroll
            for (int m = 0; m < 4; ++m) {
                const int row = row0 + ai * HALF + m * 16; const size_t off = (size_t)row * D + col0;
                const float rs = row_rstd(ssq, row);
#pragma unroll
                for (int bj = 0; bj < 2; ++bj) {
                    __builtin_nontemporal_store(acc[ai][bj][m][0] * rs * gv[bj][0], (f32x4*)(out + off + bj * HALF));
                    __builtin_nontemporal_store(acc[ai][bj][m][1] * rs * gv[bj][1], (f32x4*)(out + off + bj * HALF + 4));
                }
            }
    }
};

struct EpiSoftmax {
    static constexpr bool PERM = true;
    bf16_t* P; int ldc; const float* ssq; float scale; int pm0;
    DI void operator()(Acc& acc, const Unit& u, int wr, int wc, int fr, int fq, LAS unsigned char* scr) const {
        LAS f32x2* X = (LAS f32x2*)scr;
        const LAS float* tab = (const LAS float*)(scr + 8192);
        float mw[2][4];
#pragma unroll
        for (int ai = 0; ai < 2; ++ai)
#pragma unroll
            for (int m = 0; m < 4; ++m) {
                const float rs = ((u.pm == pm0) ? tab[ai * HALF + wr * 64 + m * 16 + fr] : row_rstd(ssq, u.pm * BM + ai * HALF + wr * 64 + m * 16 + fr)) * scale;
#pragma unroll
                for (int bj = 0; bj < 2; ++bj)
#pragma unroll
                    for (int n = 0; n < 2; ++n) acc[ai][bj][m][n] = acc[ai][bj][m][n] * rs;
                float mx = -INFINITY;
#pragma unroll
                for (int bj = 0; bj < 2; ++bj)
#pragma unroll
                    for (int n = 0; n < 2; ++n)
#pragma unroll
                        for (int e = 0; e < 4; ++e) mx = fmaxf(mx, acc[ai][bj][m][n][e]);
                mx = fmaxf(mx, __shfl_xor(mx, 16)); mx = fmaxf(mx, __shfl_xor(mx, 32));
                float s = 0.f;
#pragma unroll
                for (int bj = 0; bj < 2; ++bj)
#pragma unroll
                    for (int n = 0; n < 2; ++n)
#pragma unroll
                        for (int e = 0; e < 4; ++e) { const float p = __builtin_amdgcn_exp2f(acc[ai][bj][m][n][e] - mx); acc[ai][bj][m][n][e] = p; s += p; }
                s += __shfl_xor(s, 16); s += __shfl_xor(s, 32);
                mw[ai][m] = mx;
                if (fq == 0) X[(ai * HALF + wr * 64 + m * 16 + fr) * 4 + wc] = (f32x2){mx, s};
            }
        asm volatile("s_waitcnt lgkmcnt(0)" ::: "memory"); __builtin_amdgcn_s_barrier(); asm volatile("" ::: "memory");
        const int row0 = u.pm * BM + wr * 64 + fr, col0 = u.pn * BM + wc * 32 + 8 * fq;
#pragma unroll
        for (int ai = 0; ai < 2; ++ai)
#pragma unroll
            for (int m = 0; m < 4; ++m) {
                const int rl = ai * HALF + wr * 64 + m * 16 + fr;
                const f32x2 a = X[rl * 4 + 0], b = X[rl * 4 + 1], c = X[rl * 4 + 2], d = X[rl * 4 + 3];
                const float M = fmaxf(fmaxf(a.x, b.x), fmaxf(c.x, d.x));
                const float tot = a.y * __builtin_amdgcn_exp2f(a.x - M) + b.y * __builtin_amdgcn_exp2f(b.x - M) + c.y * __builtin_amdgcn_exp2f(c.x - M) + d.y * __builtin_amdgcn_exp2f(d.x - M);
                const float sc = __builtin_amdgcn_exp2f(mw[ai][m] - M) / tot;
                bf16_t* rowp = P + (size_t)(row0 + ai * HALF + m * 16) * ldc + col0;
#pragma unroll
                for (int bj = 0; bj < 2; ++bj) {
                    const f32x4 v0 = acc[ai][bj][m][0] * sc, v1 = acc[ai][bj][m][1] * sc;
                    u32x4 w; w.x = pk2(v0[0], v0[1]); w.y = pk2(v0[2], v0[3]); w.z = pk2(v1[0], v1[1]); w.w = pk2(v1[2], v1[3]);
                    *(u32x4*)(rowp + bj * HALF) = w;
                }
            }
        asm volatile("s_waitcnt lgkmcnt(0)" ::: "memory"); __builtin_amdgcn_s_barrier(); asm volatile("" ::: "memory");
    }
};

template <class Epi>
DI void gemm_phase(LAS unsigned char* lds, LAS unsigned char* scr, const Gemm g, const StaticOrder& S, const Epi& E) {
    int tid = threadIdx.x; asm volatile("" : "+v"(tid));
    const int wid = __builtin_amdgcn_readfirstlane(tid >> 6), lane = tid & 63, wr = wid >> 2, wc = wid & 3, fr = lane & 15, fq = lane >> 4;
    const int nt = g.K / BK;
    unsigned voffA[2], voffB[2];
#pragma unroll
    for (int i = 0; i < 2; ++i) { int R, C; stage_rc(tid * 16 + i * 8192, R, C); const int Rb = Epi::PERM ? ((R & ~31) + perm32(R & 31)) : R;
        voffA[i] = (unsigned)(R * g.lda + C) * 2u; voffB[i] = (unsigned)(Rb * g.ldb + C) * 2u; }
    const size_t kstep = (size_t)(BK * 2);
    const size_t hsA = (size_t)HALF * g.lda * 2, hsB = (size_t)HALF * g.ldb * 2;
    const unsigned ldsw = (unsigned)wid * 1024u;
    const int aoff = lds_byte(wr * 64 + fr, fq * 8), boff = lds_byte(wc * 32 + fr, fq * 8);
#define PG8_SA(b, h) (((b) * 2 + (h)) * HTB)
#define PG8_SB(b, h) ((4 + (b) * 2 + (h)) * HTB)
#define PG8_STAGE(bufoff, gbase, voff) do { _Pragma("unroll") for (int _i = 0; _i < 2; ++_i) \
        __builtin_amdgcn_global_load_lds((const unsigned*)((const char*)(gbase) + (voff)[_i]), (LAS unsigned*)(lds + (bufoff) + ldsw + _i * 8192), 16, 0, 0); } while (0)
#define PG8_LDA(dst, b, h) do { _Pragma("unroll") for (int m = 0; m < 4; ++m) _Pragma("unroll") for (int k = 0; k < 2; ++k) dst[m][k] = *(const LAS bf16x8*)(lds + PG8_SA(b, h) + aoff + m * 2048 + k * 1024); } while (0)
#define PG8_LDB(dst, b, h) do { _Pragma("unroll") for (int n = 0; n < 2; ++n) _Pragma("unroll") for (int k = 0; k < 2; ++k) dst[n][k] = *(const LAS bf16x8*)(lds + PG8_SB(b, h) + boff + n * 2048 + k * 1024); } while (0)
#define PG8_MMA(ai, bj, At, Bt) do { __builtin_amdgcn_s_setprio(1); _Pragma("unroll") for (int m = 0; m < 4; ++m) _Pragma("unroll") for (int n = 0; n < 2; ++n) _Pragma("unroll") for (int k = 0; k < 2; ++k) \
        acc[ai][bj][m][n] = __builtin_amdgcn_mfma_f32_16x16x32_bf16(Bt[n][k], At[m][k], acc[ai][bj][m][n], 0, 0, 0); __builtin_amdgcn_s_setprio(0); } while (0)
#define PG8_WAIT_V(n) asm volatile("s_waitcnt vmcnt(" #n ")" ::: "memory")
#define PG8_WAIT_L(n) asm volatile("s_waitcnt lgkmcnt(" #n ")" ::: "memory")
#define PG8_BAR __builtin_amdgcn_s_barrier()
#define PG8_SCHED __builtin_amdgcn_sched_barrier(0)
    Unit cur, nxt; int ui = 0;
    if (!S.next(0, cur)) return;
    Acc acc;
#pragma unroll
    for (int a = 0; a < 2; ++a)
#pragma unroll
        for (int b = 0; b < 2; ++b)
#pragma unroll
            for (int m = 0; m < 4; ++m)
#pragma unroll
                for (int n = 0; n < 2; ++n) acc[a][b][m][n] = (f32x4){0.f, 0.f, 0.f, 0.f};
    bf16x8 At[4][2], B0[2][2], B1[2][2];
    const char* cA = abase(g, cur); const char* cB = bbase(g, cur);
    PG8_STAGE(PG8_SB(0, 0), cB, voffB); PG8_STAGE(PG8_SB(0, 1), cB + hsB, voffB); PG8_STAGE(PG8_SA(0, 0), cA, voffA); PG8_STAGE(PG8_SA(0, 1), cA + hsA, voffA);
    if (wr == 1) PG8_BAR;
    PG8_WAIT_V(2); PG8_BAR;
    PG8_STAGE(PG8_SB(1, 0), cB + kstep, voffB); PG8_STAGE(PG8_SA(1, 0), cA + kstep, voffA); PG8_STAGE(PG8_SB(1, 1), cB + hsB + kstep, voffB);
    PG8_WAIT_V(6); PG8_BAR;
    for (;;) {
        const bool has_next = S.next(ui + 1, nxt);
        const char* nA = has_next ? abase(g, nxt) : cA; const char* nB = has_next ? bbase(g, nxt) : cB;
        for (int t = 0; t < nt; t += 2) {
            const bool last = (t == nt - 2);
            const char* a1 = cA + (size_t)(t + 1) * kstep;
            const char* a2 = last ? nA : cA + (size_t)(t + 2) * kstep; const char* b2 = last ? nB : cB + (size_t)(t + 2) * kstep;
            const char* a3 = a2 + kstep; const char* b3 = b2 + kstep;
            PG8_LDB(B0, 0, 0); PG8_LDB(B1, 0, 1); PG8_SCHED; PG8_LDA(At, 0, 0); PG8_STAGE(PG8_SA(1, 1), a1 + hsA, voffA);
            PG8_WAIT_V(8); PG8_WAIT_L(0); PG8_BAR; PG8_MMA(0, 0, At, B0); PG8_MMA(0, 1, At, B1); PG8_BAR; PG8_SCHED;
            PG8_LDA(At, 0, 1); PG8_STAGE(PG8_SB(0, 0), b2, voffB); PG8_STAGE(PG8_SB(0, 1), b2 + hsB, voffB); PG8_STAGE(PG8_SA(0, 0), a2, voffA);
            PG8_WAIT_V(8); PG8_WAIT_L(0); PG8_BAR; PG8_MMA(1, 0, At, B0); PG8_MMA(1, 1, At, B1); PG8_BAR; PG8_SCHED;
            PG8_LDB(B0, 1, 0); PG8_LDB(B1, 1, 1); PG8_SCHED; PG8_LDA(At, 1, 0); PG8_STAGE(PG8_SA(0, 1), a2 + hsA, voffA);
            PG8_WAIT_V(8); PG8_WAIT_L(0); PG8_BAR; PG8_MMA(0, 0, At, B0); PG8_MMA(0, 1, At, B1); PG8_BAR; PG8_SCHED;
            PG8_LDA(At, 1, 1); PG8_STAGE(PG8_SB(1, 0), b3, voffB); PG8_STAGE(PG8_SB(1, 1), b3 + hsB, voffB); PG8_STAGE(PG8_SA(1, 0), a3, voffA);
            PG8_WAIT_V(8); PG8_WAIT_L(0); PG8_BAR; PG8_MMA(1, 0, At, B0); PG8_MMA(1, 1, At, B1); PG8_BAR; PG8_SCHED;
        }
        if (wr == 0) PG8_BAR;
        E(acc, cur, wr, wc, fr, fq, scr);
        if (!has_next) break;
#pragma unroll
        for (int a = 0; a < 2; ++a)
#pragma unroll
            for (int b = 0; b < 2; ++b)
#pragma unroll
                for (int m = 0; m < 4; ++m)
#pragma unroll
                    for (int n = 0; n < 2; ++n) acc[a][b][m][n] = (f32x4){0.f, 0.f, 0.f, 0.f};
        cur = nxt; cA = nA; cB = nB; ++ui;
        if (wr == 1) PG8_BAR;
    }
    PG8_WAIT_V(0);
    PG8_BAR;
#undef PG8_SA
#undef PG8_SB
#undef PG8_STAGE
#undef PG8_LDA
#undef PG8_LDB
#undef PG8_MMA
#undef PG8_WAIT_V
#undef PG8_WAIT_L
#undef PG8_BAR
#undef PG8_SCHED
}
}

DI float wave_sum(float v) {
#pragma unroll
    for (int o = 1; o < 64; o <<= 1) v += __shfl_xor(v, o);
    return v;
}
struct TItem { const float* W; bf16_t* WT; const float* g; const float* g2; int K, N, rot_lo, rot_hi, item; };
DI void p0_item_load(const TItem& t, float (&v)[32], int lane) {
    const int nblk = t.N / 32, kb = t.item / nblk, nb = t.item % nblk, k0 = 64 * kb, n0 = 32 * nb;
    const int nc = lane & 7;
    const bool rot = n0 >= t.rot_lo && n0 < t.rot_hi;
    const int c0 = rot ? (n0 & ~63) + 32 * (nc >> 2) + ((n0 & 63) >> 1) + 4 * (nc & 3) : n0 + 4 * nc;
#pragma unroll
    for (int i = 0; i < 8; ++i) {
        const int k = k0 + 8 * i + (lane >> 3);
        float gv = 1.0f;
        if (t.g) gv = (t.g2 && k >= 512) ? t.g2[k - 512] : t.g[k];
        const f32x4 w = __builtin_nontemporal_load((const f32x4*)(t.W + (size_t)k * t.N + c0));
        v[4 * i + 0] = w[0] * gv; v[4 * i + 1] = w[1] * gv; v[4 * i + 2] = w[2] * gv; v[4 * i + 3] = w[3] * gv;
    }
}
DI void p0_item_finish(const TItem& t, const float (&v)[32], LAS float* scr, int lane) {
    const int nblk = t.N / 32, kb = t.item / nblk, nb = t.item % nblk, k0 = 64 * kb, n0 = 32 * nb;
    const int nc = lane & 7;
    const bool rot = n0 >= t.rot_lo && n0 < t.rot_hi;
    const int d0 = rot ? 8 * (nc & 3) + (nc >> 2) : 4 * nc, ds = rot ? 2 : 1;
#pragma unroll
    for (int i = 0; i < 8; ++i)
#pragma unroll
        for (int e = 0; e < 4; ++e) scr[(8 * i + (lane >> 3)) * 33 + d0 + e * ds] = v[4 * i + e];
    asm volatile("s_waitcnt lgkmcnt(0)" ::: "memory");
    const int c = lane & 7;
#pragma unroll
    for (int j = 0; j < 4; ++j) { const int n = (lane >> 3) + 8 * j; const LAS float* s = scr + (8 * c) * 33 + n;
        u32x4 o; o.x = pk2(s[0 * 33], s[1 * 33]); o.y = pk2(s[2 * 33], s[3 * 33]); o.z = pk2(s[4 * 33], s[5 * 33]); o.w = pk2(s[6 * 33], s[7 * 33]);
        *(u32x4*)(t.WT + (size_t)(n0 + n) * t.K + k0 + 8 * c) = o; }
    asm volatile("s_waitcnt lgkmcnt(0)" ::: "memory");
}

constexpr int SW_KOFF = 0, SW_KSTR = 272, SW_VOFF = 192 * 272, SW_VSTR = 320, SW_XOFF = SW_VOFF + 192 * 320;
static_assert(SW_XOFF + 2 * 32 * 8 * 4 <= RING_BYTES, "swa LDS");
DI int crow(int r, int hi) { return (r & 3) + 8 * (r >> 2) + 4 * hi; }
typedef short v4i16_t __attribute__((ext_vector_type(4)));
DI s16x4 vtr(LAS unsigned char* p) { return __builtin_bit_cast(s16x4, __builtin_amdgcn_ds_read_tr16_b64_v4i16((LAS v4i16_t*)p)); }

template <bool EDGE> DI void swa_conv_unit(int unit, const bf16_t* U, bf16_t* MIX, const float* convw, const float* sinks, LAS unsigned char* lds) {
    int tid = threadIdx.x; asm volatile("" : "+v"(tid));
    const int lane = tid & 63, wid = __builtin_amdgcn_readfirstlane(tid >> 6);
    const int b = unit >> 6, qt = unit & 63, q0s = qt * 64, tok0 = b * SEQ + q0s;
#pragma unroll
    for (int it = 0; it < 6; ++it) {
        const int id = it * 512 + tid, key = id >> 4, ch = id & 15;
        u32x4 kv = {0u, 0u, 0u, 0u}, vv = {0u, 0u, 0u, 0u};
        if (!EDGE || q0s - 128 + key >= 0) { const bf16_t* rowp = U + (size_t)(tok0 - 128 + key) * INC; kv = *(const u32x4*)(rowp + 2048 + ch * 8); vv = *(const u32x4*)(rowp + 2176 + ch * 8); }
        *(LAS u32x4*)(lds + SW_KOFF + key * SW_KSTR + ch * 16) = kv;
        *(LAS u32x4*)(lds + SW_VOFF + key * SW_VSTR + ch * 16) = vv;
    }
    {
        const int c0 = lane * 8, t0 = tok0 + 8 * wid, s0 = q0s + 8 * wid;
        float w0[8], w1[8], w2[8], p2[8], p1[8];
#pragma unroll
        for (int e = 0; e < 8; ++e) { w0[e] = convw[c0 + e]; w1[e] = convw[512 + c0 + e]; w2[e] = convw[1024 + c0 + e]; p2[e] = 0.f; p1[e] = 0.f; }
        if (s0 >= 2) {
            const bf16_t* r2 = U + (size_t)(t0 - 2) * INC; const bf16_t* r1 = U + (size_t)(t0 - 1) * INC;
            const u32x4 gc2 = *(const u32x4*)(r2 + 512 + c0), xc2 = *(const u32x4*)(r2 + 1024 + c0), gc1 = *(const u32x4*)(r1 + 512 + c0), xc1 = *(const u32x4*)(r1 + 1024 + c0);
#pragma unroll
            for (int e = 0; e < 4; ++e) { p2[2 * e] = bf_lo(gc2[e]) * bf_lo(xc2[e]); p2[2 * e + 1] = bf_hi(gc2[e]) * bf_hi(xc2[e]); p1[2 * e] = bf_lo(gc1[e]) * bf_lo(xc1[e]); p1[2 * e + 1] = bf_hi(gc1[e]) * bf_hi(xc1[e]); }
        }
#pragma unroll 2
        for (int j = 0; j < 8; ++j) {
            const bf16_t* r = U + (size_t)(t0 + j) * INC;
            const u32x4 gb = *(const u32x4*)(r + c0), gc = *(const u32x4*)(r + 512 + c0), xc = *(const u32x4*)(r + 1024 + c0);
            float pc[8], o[8]; float ss = 0.f;
#pragma unroll
            for (int e = 0; e < 4; ++e) { pc[2 * e] = bf_lo(gc[e]) * bf_lo(xc[e]); pc[2 * e + 1] = bf_hi(gc[e]) * bf_hi(xc[e]); }
#pragma unroll
            for (int e = 0; e < 8; ++e) {
                const float cv = w0[e] * p2[e] + w1[e] * p1[e] + w2[e] * pc[e];
                const float gbv = (e & 1) ? bf_hi(gb[e >> 1]) : bf_lo(gb[e >> 1]);
                o[e] = gbv * cv; ss += o[e] * o[e];
            }
            ss = wave_sum(ss);
            const float rs = 1.0f / sqrtf(ss * (1.0f / 512.0f) + EPS);
            u32x4 w; w.x = pk2(o[0] * rs, o[1] * rs); w.y = pk2(o[2] * rs, o[3] * rs); w.z = pk2(o[4] * rs, o[5] * rs); w.w = pk2(o[6] * rs, o[7] * rs);
            *(u32x4*)(MIX + (size_t)(t0 + j) * D + c0) = w;
#pragma unroll
            for (int e = 0; e < 8; ++e) { p2[e] = p1[e]; p1[e] = pc[e]; }
        }
    }
    const int h = wid, kvh = h >> 2, r32 = lane & 31, hi = lane >> 5;
    const float sink2 = sinks[h] * LOG2E;
    __syncthreads();
    LAS float* X = (LAS float*)(lds + SW_XOFF);
    const int qq = (lane & 15) >> 2, pp = lane & 3, gg = (lane >> 4) & 1;
#pragma unroll 1
    for (int qs = 0; qs < 2; ++qs) {
        bf16x8 qf[4];
#pragma unroll
        for (int kb = 0; kb < 4; ++kb) qf[kb] = *(const bf16x8*)(U + (size_t)(tok0 + 32 * qs + r32) * INC + 1536 + h * 64 + 16 * kb + 8 * hi);
        f32x16 st[5];
#pragma unroll
        for (int kt = 0; kt < 5; ++kt) {
#pragma unroll
            for (int r = 0; r < 16; ++r) st[kt][r] = 0.f;
#pragma unroll
            for (int kb = 0; kb < 4; ++kb) {
                const bf16x8 kf = *(const LAS bf16x8*)(lds + SW_KOFF + (32 * (qs + kt) + r32) * SW_KSTR + (kvh * 64 + 16 * kb + 8 * hi) * 2);
                st[kt] = __builtin_amdgcn_mfma_f32_32x32x16_bf16(kf, qf[kb], st[kt], 0, 0, 0);
            }
        }
        float mx = sink2;
        const int kpos0 = q0s + 32 * qs - 128;
        if constexpr (EDGE) {
#pragma unroll
            for (int kt = 0; kt < 5; ++kt)
#pragma unroll
                for (int r = 0; r < 16; ++r) {
                    const int kr = 32 * kt + crow(r, hi);
                    const bool valid = (kr > r32) && (kr <= r32 + 128) && (kpos0 + kr >= 0);
                    const float v = valid ? st[kt][r] : -INFINITY;
                    st[kt][r] = v; mx = fmaxf(mx, v);
                }
        } else {
#pragma unroll
            for (int r = 0; r < 16; ++r) {
                const int c = crow(r, hi);
                const float v0 = (c > r32) ? st[0][r] : -INFINITY, v4 = (c <= r32) ? st[4][r] : -INFINITY;
                st[0][r] = v0; st[4][r] = v4; mx = fmaxf(mx, fmaxf(v0, v4));
            }
#pragma unroll
            for (int kt = 1; kt < 4; ++kt)
#pragma unroll
                for (int r = 0; r < 16; ++r) mx = fmaxf(mx, st[kt][r]);
        }
        mx = fmaxf(mx, __shfl_xor(mx, 32));
        float sum = 0.f;
#pragma unroll
        for (int kt = 0; kt < 5; ++kt)
#pragma unroll
            for (int r = 0; r < 16; ++r) { const float p = __builtin_amdgcn_exp2f(st[kt][r] - mx); st[kt][r] = p; sum += p; }
        sum += __shfl_xor(sum, 32);
        sum += __builtin_amdgcn_exp2f(sink2 - mx);
        const float inv = 1.0f / sum;
        f32x16 o[2];
#pragma unroll
        for (int r = 0; r < 16; ++r) { o[0][r] = 0.f; o[1][r] = 0.f; }
#pragma unroll
        for (int kt = 0; kt < 5; ++kt)
#pragma unroll
            for (int s = 0; s < 2; ++s) {
                u32x4 pw; pw.x = pk2(st[kt][8 * s + 0], st[kt][8 * s + 1]); pw.y = pk2(st[kt][8 * s + 2], st[kt][8 * s + 3]); pw.z = pk2(st[kt][8 * s + 4], st[kt][8 * s + 5]); pw.w = pk2(st[kt][8 * s + 6], st[kt][8 * s + 7]);
                const bf16x8 pf = __builtin_bit_cast(bf16x8, pw);
#pragma unroll
                for (int dt = 0; dt < 2; ++dt) {
                    LAS unsigned char* vb = lds + SW_VOFF + (32 * (qs + kt) + 16 * s + 4 * hi + qq) * SW_VSTR + (kvh * 64 + 32 * dt + 16 * gg) * 2 + 8 * pp;
                    const s16x4 lo = vtr(vb), hi4 = vtr(vb + 8 * SW_VSTR);
                    const bf16x8 vf = __builtin_shufflevector(lo, hi4, 0, 1, 2, 3, 4, 5, 6, 7);
                    o[dt] = __builtin_amdgcn_mfma_f32_32x32x16_bf16(vf, pf, o[dt], 0, 0, 0);
                }
            }
        float ss = 0.f;
#pragma unroll
        for (int dt = 0; dt < 2; ++dt)
#pragma unroll
            for (int r = 0; r < 16; ++r) { o[dt][r] *= inv; ss += o[dt][r] * o[dt][r]; }
        ss += __shfl_xor(ss, 32);
        if (hi == 0) X[(qs * 32 + r32) * 8 + h] = ss;
        __syncthreads();
        const f32x4 xa = *(const LAS f32x4*)(X + (qs * 32 + r32) * 8), xb4 = *(const LAS f32x4*)(X + (qs * 32 + r32) * 8 + 4);
        const float tot = ((xa[0] + xa[1]) + (xa[2] + xa[3])) + ((xb4[0] + xb4[1]) + (xb4[2] + xb4[3]));
        const float rs = 1.0f / sqrtf(tot * (1.0f / 512.0f) + EPS);
        bf16_t* orow = MIX + (size_t)(tok0 + 32 * qs + r32) * D + 512 + h * 64 + 4 * hi;
#pragma unroll
        for (int dt = 0; dt < 2; ++dt)
#pragma unroll
            for (int g4 = 0; g4 < 4; ++g4) {
                u32x2 w; w.x = pk2(o[dt][4 * g4 + 0] * rs, o[dt][4 * g4 + 1] * rs); w.y = pk2(o[dt][4 * g4 + 2] * rs, o[dt][4 * g4 + 3] * rs);
                *(u32x2*)(orow + 32 * dt + 8 * g4) = w;
            }
    }
    __syncthreads();
}

#define XB_TMO      128
#define XB_XCNT(j)  (256  + 64 * (j))
#define XB_XSUB(j)  (1280 + 64 * (j))
#define XB_XGEN(j)  (2304 + 64 * (j))
#define XB_TOP      3328
#define XB_TOPGEN   3392
#define XCD_BAR_WORDS 3456
#define XB_SPIN_CAP (1u << 18)
DI unsigned xb_ld(unsigned* p)              { return __hip_atomic_load(p, __ATOMIC_RELAXED, __HIP_MEMORY_SCOPE_AGENT); }
DI unsigned xb_add(unsigned* p, unsigned v) { return __hip_atomic_fetch_add(p, v, __ATOMIC_RELAXED, __HIP_MEMORY_SCOPE_AGENT); }
DI unsigned xb_xcc_id() { return (unsigned)__builtin_amdgcn_s_getreg((3 << 11) | 20) & 0xFu; }
#define XB_SPIN(cond, bar) do { unsigned _sp = 0; while (cond) { __builtin_amdgcn_s_sleep(1); \
    if ((++_sp & 255u) == 0u) { if (xb_ld(&(bar)[XB_TMO])) break; if (_sp > XB_SPIN_CAP) { atomicAdd(&(bar)[XB_TMO], 1u); break; } } } } while (0)
struct XcdBarrier { unsigned* bar; unsigned x; volatile LAS unsigned* st; };
DI XcdBarrier xcd_barrier_post(unsigned* bar, volatile LAS unsigned* st) {
    XcdBarrier b; b.bar = bar; b.x = xb_xcc_id(); b.st = st;
    if (threadIdx.x == 0) st[4] = xb_add(&bar[XB_XCNT(b.x)], 1u);
    return b;
}
DI void team_barrier_at(unsigned* cnt, unsigned* bar, unsigned gen) {
    asm volatile("s_waitcnt vmcnt(0)" ::: "memory");
    __syncthreads();
    if (threadIdx.x == 0) {
        __builtin_amdgcn_s_waitcnt(0);
        (void)xb_add(cnt, 1u);
        const unsigned target = 4u * (gen + 1u);
        XB_SPIN(xb_ld(cnt) < target, bar);
        __builtin_amdgcn_fence(__ATOMIC_ACQUIRE, "agent");
        asm volatile("s_waitcnt vmcnt(0)" ::: "memory");
    }
    __syncthreads();
}
DI void team_barrier(unsigned* cnt, unsigned* bar, unsigned& gen) { team_barrier_at(cnt, bar, gen); ++gen; }
DI void guard_wait(unsigned* w, unsigned target, unsigned* bar) {
    if (threadIdx.x == 0) { XB_SPIN(xb_ld(w) < target, bar); }
    __syncthreads();
}
DI void xcd_barrier_complete(unsigned* bar, unsigned x, unsigned& nloc, unsigned& nx) {
    const unsigned G = gridDim.x * gridDim.y * gridDim.z;
    unsigned sum, cnt, mine, sp = 0u;
    for (;;) {
        sum = 0u; cnt = 0u; mine = 0u;
#pragma unroll
        for (unsigned j = 0; j < 16; ++j) { const unsigned c = xb_ld(&bar[XB_XCNT(j)]); sum += c; cnt += (c > 0u) ? 1u : 0u; mine = (j == x) ? c : mine; }
        if (sum == G) break;
        __builtin_amdgcn_s_sleep(1);
        if ((++sp & 255u) == 0u) { if (xb_ld(&bar[XB_TMO])) break; if (sp > XB_SPIN_CAP) { atomicAdd(&bar[XB_TMO], 1u); break; } }
    }
    nloc = mine > 0u ? mine : 1u; nx = cnt > 0u ? cnt : 1u;
}
DI void xcd_barrier(const XcdBarrier& b) {
    asm volatile("s_waitcnt vmcnt(0)" ::: "memory");
    __syncthreads();
    if (threadIdx.x == 0) {
        unsigned* bar = b.bar;
        __builtin_amdgcn_s_waitcnt(0);
        unsigned nloc = b.st[0], nx = b.st[1];
        if (nloc == 0u) { xcd_barrier_complete(bar, b.x, nloc, nx); b.st[0] = nloc; b.st[1] = nx; }
        const unsigned old = xb_add(&bar[XB_XSUB(b.x)], 1u);
        const unsigned gen = old / nloc;
        if (old + 1u == (gen + 1u) * nloc) {
            __builtin_amdgcn_fence(__ATOMIC_RELEASE, "agent");
            asm volatile("s_waitcnt vmcnt(0)" ::: "memory");
            const unsigned og = xb_add(&bar[XB_TOP], 1u);
            const unsigned tg = og / nx;
            if (og + 1u == (tg + 1u) * nx) xb_add(&bar[XB_TOPGEN], 1u);
            else XB_SPIN(xb_ld(&bar[XB_TOPGEN]) == tg, bar);
            __builtin_amdgcn_fence(__ATOMIC_ACQUIRE, "agent");
            xb_add(&bar[XB_XGEN(b.x)], 1u);
            asm volatile("s_waitcnt vmcnt(0)" ::: "memory");
        } else {
            XB_SPIN(xb_ld(&bar[XB_XGEN(b.x)]) == gen, bar);
            __builtin_amdgcn_fence(__ATOMIC_ACQUIRE, "agent");
            asm volatile("s_waitcnt vmcnt(0)" ::: "memory");
        }
    }
    __syncthreads();
}

DI int fill_rstd_table(const pg8::StaticOrder& S, const float* ssq, LAS unsigned char* scr) {
    pg8::Unit u0; const bool any = S.next(0, u0);
    int tid = threadIdx.x; asm volatile("" : "+v"(tid));
    if (any && tid < 256) ((LAS float*)(scr + 8192))[tid] = row_rstd(ssq, u0.pm * 256 + tid);
    __syncthreads();
    return any ? u0.pm : -1;
}

struct Args { const void* in[19]; float* out; unsigned char* ws; int ph_lo, ph_hi; };
constexpr int N_PHASES = 20;

__global__ void __launch_bounds__(512, 2) mk_fwd(Args args) {
    extern __shared__ __attribute__((aligned(16))) unsigned char lds_raw[];
    LAS unsigned char* lds = (LAS unsigned char*)lds_raw;
    LAS unsigned char* scr = lds + SCR_OFF;
    const int tid = threadIdx.x, lane = tid & 63, wid = __builtin_amdgcn_readfirstlane(tid >> 6);
    const int G = gridDim.x, bx = blockIdx.x;
    const int vcu = (G % 8 == 0) ? (bx % 8) * (G / 8) + bx / 8 : bx;
    const int gw = vcu * 8 + wid, NGW = G * 8;
    const int lo = args.ph_lo, hi = args.ph_hi;
#define IN(k) (lo <= (k) && (k) < hi)
#define SEAM(k) do { if (IN(k) && IN((k) + 1)) { xcd_barrier(bar); } } while (0)
#define TSEAM(k) do { if (IN(k) && IN((k) + 1)) { if (fast) team_barrier(tcnt, bar.bar, tgen); else xcd_barrier(bar); } } while (0)
    volatile LAS unsigned* MISC = (volatile LAS unsigned*)(lds + RING_BYTES);
    if (tid < 64) MISC[tid] = 0u;
    __syncthreads();
    XcdBarrier bar; bar.bar = (unsigned*)args.ws; bar.x = 0; bar.st = MISC + 8;
    if (hi - lo > 1) bar = xcd_barrier_post((unsigned*)args.ws, MISC + 8);

    const float* x_in = (const float*)args.in[0];
    const float* mem = (const float*)args.in[1];
    const int* positions = (const int*)args.in[2];
    const float* norm_mix_g = (const float*)args.in[3];
    const float* w_in = (const float*)args.in[4];
    const float* conv_w = (const float*)args.in[5];
    const float* sinks = (const float*)args.in[6];
    const float* gnorm_conv_g = (const float*)args.in[7];
    const float* gnorm_attn_g = (const float*)args.in[8];
    const float* w_out = (const float*)args.in[9];
    const float* norm_x_g = (const float*)args.in[10];
    const float* norm_mem_g = (const float*)args.in[11];
    const float* wx_q = (const float*)args.in[12];
    const float* wx_kv = (const float*)args.in[13];
    const float* wx_o = (const float*)args.in[14];
    const float* norm_mlp_g = (const float*)args.in[15];
    const float* w_up = (const float*)args.in[16];
    const float* w_down = (const float*)args.in[17];
    const float* final_g = (const float*)args.in[18];
    float* out = args.out;
    unsigned char* ws = args.ws;
    float* SSQ = (float*)(ws + WS_SSQ);
    bf16_t* XB = (bf16_t*)(ws + WS_XB);
    bf16_t* U = (bf16_t*)(ws + WS_U);
    bf16_t* MIX = (bf16_t*)(ws + WS_MIX);
    bf16_t* QX = (bf16_t*)out;
    bf16_t* PB = (bf16_t*)out;
    bf16_t* OX = (bf16_t*)out;
    bf16_t* HB = (bf16_t*)(ws + WS_H);
    bf16_t* MEMN = (bf16_t*)(ws + WS_MEMN);
    float* ROT = (float*)(ws + WS_ROT);
#define WPTR(l, off) ((bf16_t*)(ws + WS_W + (size_t)(l) * LW_STRIDE + (off)))
#define KVM(l) ((bf16_t*)(ws + WS_KMEM + (size_t)(l) * 4 * MiB))
    bf16_t* VPT = (bf16_t*)(ws + WS_VP);
    bf16_t* WPP = (bf16_t*)(ws + WS_VP + 8 * MiB);

        constexpr int I_IN = 16 * 72, I_SQ = 16 * 32, I_KV = 16 * 64, I_UP = 16 * 128, I_DN = 64 * 32;
        constexpr int I_LAYER = I_IN + I_SQ + I_KV + I_SQ + I_UP + I_DN;
        auto decode = [&](int it) -> TItem {
            const int l = it / I_LAYER; int r = it % I_LAYER;
            if (r < I_IN) return TItem{w_in + (size_t)l * D * INC, WPTR(l, LW_IN), norm_mix_g + l * D, nullptr, D, INC, 1536, 2176, r}; r -= I_IN;
            if (r < I_SQ) return TItem{w_out + (size_t)l * D * D, WPTR(l, LW_OUT), gnorm_conv_g + l * 512, gnorm_attn_g + l * 512, D, D, 0, 0, r}; r -= I_SQ;
            if (r < I_KV) return TItem{wx_kv + (size_t)l * D * 2 * D, WPTR(l, LW_KV), norm_mem_g + l * D, nullptr, D, 2 * D, 0, 0, r}; r -= I_KV;
            if (r < I_SQ) return TItem{wx_o + (size_t)l * D * D, WPTR(l, LW_O), nullptr, nullptr, D, D, 0, 0, r}; r -= I_SQ;
            if (r < I_UP) return TItem{w_up + (size_t)l * D * FF, WPTR(l, LW_UP), norm_mlp_g + l * D, nullptr, D, FF, 0, 0, r}; r -= I_UP;
            return TItem{w_down + (size_t)l * FF * D, WPTR(l, LW_DN), nullptr, nullptr, FF, D, 0, 0, r};
        };
    constexpr int NIF = 4;
    constexpr int N_EARLY = I_LAYER + I_IN + I_KV + I_SQ, N_LATE = I_SQ + I_UP + I_DN;
    auto early_it = [&](int e) -> int { const int e1 = e - I_LAYER; return e < I_LAYER ? e : I_LAYER + (e1 < I_IN ? e1 : e1 + I_SQ); };
    auto late_it = [&](int j) -> int { return I_LAYER + I_IN + (j < I_SQ ? j : j + I_KV + I_SQ); };
    if (IN(0)) for (int rep = 0; rep < REP0; ++rep) {
        LAS float* tsc = (LAS float*)(lds + wid * 16384);
        {
            const int n_now = (G >= 256) ? N_EARLY : N_EARLY + N_LATE;
            for (int e = gw; e < n_now; e += NIF * NGW) {
                float v[NIF][32];
#pragma unroll
                for (int q = 0; q < NIF; ++q) { const int eq = e + q * NGW; if (eq < n_now) { const TItem t = decode(eq < N_EARLY ? early_it(eq) : late_it(eq - N_EARLY)); p0_item_load(t, v[q], lane); } }
#pragma unroll
                for (int q = 0; q < NIF; ++q) { const int eq = e + q * NGW; if (eq < n_now) { const TItem t = decode(eq < N_EARLY ? early_it(eq) : late_it(eq - N_EARLY)); p0_item_finish(t, v[q], tsc, lane); } }
            }
        }
        constexpr int NROWS = T + MROWS + DEPTH * D;
        for (int m0 = gw; m0 < NROWS; m0 += 2 * NGW) {
            f32x4 v[2][4];
#pragma unroll
            for (int q = 0; q < 2; ++q) {
                const int m = m0 + q * NGW;
                if (m < NROWS) {
                    const float* src = (m < T) ? x_in + (size_t)m * D : (m < T + MROWS) ? mem + (size_t)(m - T) * D : wx_q + (size_t)(m - T - MROWS) * D;
                    const f32x4* xr = (const f32x4*)src + lane;
#pragma unroll
                    for (int j = 0; j < 4; ++j) v[q][j] = __builtin_nontemporal_load(xr + 64 * j);
                }
            }
#pragma unroll
            for (int q = 0; q < 2; ++q) {
                const int m = m0 + q * NGW;
                if (m < NROWS) {
                    const bool isx = m < T, ismem = !isx && m < T + MROWS; const int row = isx ? m : ismem ? m - T : m - T - MROWS;
                    float rs = 1.0f;
                    if (isx || ismem) {
                        float s = 0.f;
#pragma unroll
                        for (int j = 0; j < 4; ++j) s += (v[q][j][0] * v[q][j][0] + v[q][j][1] * v[q][j][1]) + (v[q][j][2] * v[q][j][2] + v[q][j][3] * v[q][j][3]);
                        s = wave_sum(s);
                        if (ismem) rs = 1.0f / sqrtf(s * (1.0f / 1024.0f) + EPS);
                        else if (lane < 16) SSQ[(size_t)row * 16 + lane] = (lane == 0) ? s : 0.f;
                    } else rs = norm_x_g[row];
                    bf16_t* dst = isx ? XB + (size_t)row * D : ismem ? MEMN + (size_t)row * D : WPTR(row >> 10, LW_Q) + (size_t)(row & 1023) * D;
                    u32x2* o8 = (u32x2*)dst + lane;
#pragma unroll
                    for (int j = 0; j < 4; ++j) { u32x2 w; w.x = pk2(v[q][j][0] * rs, v[q][j][1] * rs); w.y = pk2(v[q][j][2] * rs, v[q][j][3] * rs); o8[64 * j] = w; }
                }
            }
        }
        for (int idx = (vcu * 512 + tid); idx < T * 32; idx += G * 512) {
            const int tok = idx >> 5, i = idx & 31;
            double f = 1.0; for (int k = 0; k < i; ++k) f *= 0.74989420933245582730;
            const float inv = (float)f;
            const float ang = (float)positions[tok] * inv;
            double rev = (double)ang * 0.15915494309189533577; rev -= __builtin_rint(rev);
            const float rv = (float)rev;
            f32x2 cs = {__builtin_amdgcn_cosf(rv), __builtin_amdgcn_sinf(rv)};
            *(f32x2*)(ROT + (size_t)idx * 2) = cs;
        }
    }
    SEAM(0);
    if (tid == 0) {
        unsigned fastv = 0u, xv = (unsigned)bx % 8u, offv = (unsigned)bx / 8u;
        if (hi - lo > 1 && G == 256) {
            unsigned npop = 0u, ok = 1u, below = 0u;
#pragma unroll
            for (unsigned j = 0; j < 16; ++j) { const unsigned c = xb_ld(&bar.bar[XB_XCNT(j)]); if (c) { ++npop; if (c != 32u) ok = 0u; if (j < bar.x) ++below; } }
            if (FORCE_FALLBACK == 0 && ok && npop == 8u && xb_ld(&bar.bar[XB_TMO]) == 0u) { fastv = 1u; xv = below; offv = MISC[12]; }
        }
        MISC[16] = fastv; MISC[17] = xv; MISC[18] = offv;
    }
    __syncthreads();
    const bool fast = MISC[16] != 0u;
    const int vx = (int)MISC[17], voff = (int)MISC[18];
    const int cc = (G % 8 == 0) ? voff * 8 + vx : bx;
    unsigned* tcnt = (unsigned*)args.ws + 4096 + (vx * 8 + (voff & 7)) * 64;
    unsigned tgen = 0u;
    unsigned* war3 = (unsigned*)args.ws + 8192; unsigned* war6 = (unsigned*)args.ws + 8192 + 64; unsigned* war8 = (unsigned*)args.ws + 8192 + 128; unsigned* war5 = (unsigned*)args.ws + 8192 + 192;

#pragma unroll 1
    for (int l = 0; l < DEPTH; ++l) {
        const int pb = 1 + 9 * l;
        if (IN(pb + 0)) for (int rep = 0; rep < REP1; ++rep) {
            { pg8::Gemm g = pg8::std_gemm(XB, WPTR(l, LW_IN), D, D, D, T / 256, INC / 256); pg8::StaticOrder S; S.init(T / 256, INC / 256, G, cc);
              pg8::EpiWin E{U, SSQ, ROT, fill_rstd_table(S, SSQ, scr), (fast && l > 0) ? war8 : nullptr, (unsigned)G * (unsigned)l, bar.bar}; pg8::gemm_phase(lds, scr, g, S, E); }
            if (l == 0) {
#pragma unroll 1
                for (int j = 0; j < 2; ++j) {
                    pg8::Gemm g = pg8::std_gemm(MEMN, WPTR(j, LW_KV), D, D, D, 4, 8); pg8::StaticOrder S; S.init(4, 8, G, (cc + 4 * G - 64 - 32 * j) % G);
                    pg8::EpiScale<0> E{KVM(j), 2 * D, nullptr, 1.0f}; pg8::gemm_phase(lds, scr, g, S, E);
                }
                if (G >= 256 && cc >= 128) {
                    int tid2 = threadIdx.x; asm volatile("" : "+v"(tid2));
                    const int lane2 = tid2 & 63, wid2 = __builtin_amdgcn_readfirstlane(tid2 >> 6);
                    LAS float* tsc2 = (LAS float*)(lds + wid2 * 16384);
                    const int lw = (cc - 128) * 8 + wid2, NLW = (G - 128) * 8;
#pragma unroll 1
                    for (int j0 = lw; j0 < N_LATE; j0 += NLW) {
                        float v[32];
                        const TItem t = decode(late_it(j0));
                        p0_item_load(t, v, lane2);
                        p0_item_finish(t, v, tsc2, lane2);
                    }
                    __syncthreads();
                }
            } else {
                if (fast) guard_wait(war6, (unsigned)G * (unsigned)l, bar.bar);
                { pg8::Gemm g{WPTR(l, LW_O), KVM(l) + D, 256, D, 2 * D, 16, 4, 4, 0, 256L * D, 256, 4, 256L * 2 * D, 0, 256}; pg8::StaticOrder S; S.init(16, 4, G, (cc + 4 * G - 64) % G);
                  pg8::EpiScale<0> E{VPT, D, nullptr, 1.0f}; pg8::gemm_phase(lds, scr, g, S, E); }
                if (fast) guard_wait(war5, (unsigned)G * (unsigned)l, bar.bar);
                { pg8::Gemm g{KVM(l), WPTR(l, LW_Q), 256, 2 * D, D, 16, 4, 4, 256L * 2 * D, 256, 0, 4, 0, 256, 256L * D}; pg8::StaticOrder S; S.init(16, 4, G, (cc + 4 * G - 128) % G);
                  pg8::EpiScale<0> E{WPP, D, nullptr, 1.0f}; pg8::gemm_phase(lds, scr, g, S, E); }
            }
        }
        SEAM(pb + 0);
        if (IN(pb + 1)) for (int rep = 0; rep < REP2; ++rep) {
            const int unit0 = fast ? ((8 * vx + (voff & 7)) * 4 + (voff >> 3)) : vcu;
            for (int unit = unit0; unit < NB * 64; unit += G) {
                if ((unit & 63) >= 2) swa_conv_unit<false>(unit, U, MIX, conv_w + l * 3 * 512, sinks + l * 8, lds);
                else swa_conv_unit<true>(unit, U, MIX, conv_w + l * 3 * 512, sinks + l * 8, lds);
            }
        }
        if (l == 0 && IN(pb + 1)) {
            { pg8::Gemm g{WPTR(0, LW_O), KVM(0) + D, 256, D, 2 * D, 16, 4, 4, 0, 256L * D, 256, 4, 256L * 2 * D, 0, 256}; pg8::StaticOrder S; S.init(16, 4, G, cc);
              pg8::EpiScale<0> E{VPT, D, nullptr, 1.0f}; pg8::gemm_phase(lds, scr, g, S, E); }
            { pg8::Gemm g{KVM(0), WPTR(0, LW_Q), 256, 2 * D, D, 16, 4, 4, 256L * 2 * D, 256, 0, 4, 0, 256, 256L * D}; pg8::StaticOrder S; S.init(16, 4, G, (cc + 4 * G - 64) % G);
              pg8::EpiScale<0> E{WPP, D, nullptr, 1.0f}; pg8::gemm_phase(lds, scr, g, S, E); }
        }
        if (l == 0) SEAM(pb + 1); else TSEAM(pb + 1);
        if (IN(pb + 2)) {
            pg8::Gemm g = pg8::std_gemm(MIX, WPTR(l, LW_OUT), D, D, D, T / 256, 4); pg8::StaticOrder S; S.init(T / 256, 4, G, cc);
            if (l == 0) { pg8::EpiResid<0> E{x_in, out, XB, SSQ}; pg8::gemm_phase(lds, scr, g, S, E); } else { pg8::EpiResid<1> E{x_in, out, XB, SSQ}; pg8::gemm_phase(lds, scr, g, S, E); }
        }
        TSEAM(pb + 2);
        if (fast && tid == 0) (void)xb_add(war3, 1u);
        if (IN(pb + 3)) for (int rep = 0; rep < REP4; ++rep) {
            pg8::Gemm g{XB, WPP, D, D, D, T / 256, 4, 1, 256L * D, 0, 0, 16, (long)D * D, 0, 256L * D}; pg8::StaticOrder S; S.init(T / 256, 4, G, cc);
            pg8::EpiSoftmax E{PB, D, SSQ, XSCALE, fill_rstd_table(S, SSQ, scr)}; pg8::gemm_phase(lds, scr, g, S, E);
        }
        if (fast && tid == 0) (void)xb_add(war5, 1u);
        TSEAM(pb + 4);
        if (IN(pb + 6)) {
            pg8::Gemm g{PB, VPT, D, D, D, T / 256, 4, 1, 256L * D, 0, 0, 16, (long)D * D, 0, 256L * D}; pg8::StaticOrder S; S.init(T / 256, 4, G, cc);
            pg8::EpiResid<1> E{x_in, out, XB, SSQ}; pg8::gemm_phase(lds, scr, g, S, E);
        }
        if (fast) { if (IN(pb + 6) && IN(pb + 7)) { team_barrier(tcnt, bar.bar, tgen); if (tid == 0) (void)xb_add(war6, 1u); guard_wait(war3, (unsigned)G * (unsigned)(l + 1), bar.bar); } }
        else SEAM(pb + 6);
        if (IN(pb + 7)) for (int rep = 0; rep < REP7; ++rep) {
            pg8::Gemm g = pg8::std_gemm(XB, WPTR(l, LW_UP), D, D, D, T / 256, FF / 256); pg8::StaticOrder S; S.init(T / 256, FF / 256, G, cc);
            pg8::EpiScale<1> E{HB, FF, SSQ, 1.0f, fill_rstd_table(S, SSQ, scr)}; pg8::gemm_phase(lds, scr, g, S, E);
        }
        TSEAM(pb + 7);
        if (IN(pb + 8)) {
            pg8::Gemm g = pg8::std_gemm(HB, WPTR(l, LW_DN), FF, FF, FF, T / 256, 4); pg8::StaticOrder S; S.init(T / 256, 4, G, cc);
            if (l == DEPTH - 1) {
                if (fast) guard_wait(war6, (unsigned)G * (unsigned)DEPTH, bar.bar);
                if (fast) { pg8::EpiFinal E{out, XB, SSQ, final_g, tcnt, bar.bar, tgen}; pg8::gemm_phase(lds, scr, g, S, E); ++tgen; }
                else { pg8::EpiResid<2> E{x_in, out, XB, SSQ}; pg8::gemm_phase(lds, scr, g, S, E); }
            } else { pg8::EpiResid<1> E{x_in, out, XB, SSQ}; pg8::gemm_phase(lds, scr, g, S, E); }
        }
        if (fast) {
            if (l < DEPTH - 1 && IN(pb + 8) && IN(pb + 9)) { if (tid == 0) (void)xb_add(war8, 1u); team_barrier(tcnt, bar.bar, tgen); }
        } else SEAM(pb + 8);
    }
    if (IN(19) && !fast) {
        for (int m = gw; m < T; m += NGW) {
            const float rs = row_rstd(SSQ, m);
            f32x4* xr = (f32x4*)(out + (size_t)m * D) + lane; const f32x4* gr = (const f32x4*)final_g + lane;
#pragma unroll
            for (int j = 0; j < 4; ++j) { const f32x4 v = xr[64 * j], gv = gr[64 * j]; xr[64 * j] = v * rs * gv; }
        }
    }
#undef IN
#undef SEAM
#undef TSEAM
}

extern "C" void kernel_launch(void* const* d_in, const int* in_sizes, int n_in, void* d_out, int out_size, void* d_ws, size_t ws_size, hipStream_t stream) {
    static int grid = 0;
    if (grid == 0) {
        if (n_in != 19 || in_sizes[0] != T * D || out_size != T * D || ws_size < WS_END) { fprintf(stderr, "kernel_launch: unexpected shapes (n_in %d, in0 %d, out %d, ws %zu)\n", n_in, n_in > 0 ? in_sizes[0] : -1, out_size, ws_size); grid = -1; return; }
        int dev = 0, cus = 0, per_cu = 0;
        if (hipGetDevice(&dev) != hipSuccess || hipDeviceGetAttribute(&cus, hipDeviceAttributeMultiprocessorCount, dev) != hipSuccess) { grid = -1; return; }
        if (hipFuncSetAttribute((const void*)mk_fwd, hipFuncAttributeMaxDynamicSharedMemorySize, LDS_BYTES) != hipSuccess) { fprintf(stderr, "kernel_launch: hipFuncSetAttribute failed\n"); grid = -1; return; }
        if (hipOccupancyMaxActiveBlocksPerMultiprocessor(&per_cu, (const void*)mk_fwd, 512, LDS_BYTES) != hipSuccess || per_cu < 1) { fprintf(stderr, "kernel_launch: occupancy query failed (%d)\n", per_cu); (void)hipGetLastError(); grid = -1; return; }
        grid = cus * per_cu;
    }
    if (grid < 0) return;
    Args a{};
    for (int i = 0; i < 19; ++i) a.in[i] = d_in[i];
    a.out = (float*)d_out; a.ws = (unsigned char*)d_ws;
    if (hipMemsetAsync(d_ws, 0, 65536, stream) != hipSuccess) { fprintf(stderr, "kernel_launch: memset of barrier words failed\n"); return; }
#if MK_MULTI
    for (int p = 0; p < N_PHASES; ++p) {
        a.ph_lo = p; a.ph_hi = p + 1;
        hipLaunchKernelGGL(mk_fwd, dim3(grid), dim3(512), LDS_BYTES, stream, a);
    }
#else
    a.ph_lo = 0; a.ph_hi = N_PHASES;
    void* kargs[] = {&a};
    hipError_t e = hipLaunchCooperativeKernel((const void*)mk_fwd, dim3(grid), dim3(512), kargs, LDS_BYTES, stream);
    if (e != hipSuccess) fprintf(stderr, "cooperative launch failed: %s (grid %d)\n", hipGetErrorString(e), grid);
#endif
}
```

```cpp
#include <hip/hip_runtime.h>
#include <hip/hip_cooperative_groups.h>
#include <cstdio>
#include <cstdint>
namespace cg = cooperative_groups;

#ifndef REP0
#define REP0 1
#endif
#ifndef REP1
#define REP1 1
#endif
#ifndef REP2
#define REP2 1
#endif
#ifndef REP4
#define REP4 1
#endif
#ifndef REP5
#define REP5 1
#endif
#ifndef REP7
#define REP7 1
#endif
#ifndef FORCE_FALLBACK
#define FORCE_FALLBACK 0
#endif
#ifndef MK_MULTI
#define MK_MULTI 0
#endif

#define DI __device__ __forceinline__
#define LAS __attribute__((address_space(3)))
typedef unsigned short bf16_t;
typedef short bf16x8 __attribute__((ext_vector_type(8)));
typedef short s16x4 __attribute__((ext_vector_type(4)));
typedef float f32x2 __attribute__((ext_vector_type(2)));
typedef float f32x4 __attribute__((ext_vector_type(4)));
typedef float f32x16 __attribute__((ext_vector_type(16)));
typedef unsigned u32x2 __attribute__((ext_vector_type(2)));
typedef unsigned u32x4 __attribute__((ext_vector_type(4)));
typedef __bf16 bf16x2_t __attribute__((ext_vector_type(2)));

constexpr int NB = 4, SEQ = 4096, T = NB * SEQ, D = 1024, NMEM = 256, MROWS = NB * NMEM, INC = 2304, FF = 4096, DEPTH = 2;
constexpr float EPS = 1e-6f, LOG2E = 1.4426950408889634f;
constexpr float QSCALE = 0.125f * LOG2E;
constexpr float XSCALE = 0.0625f * LOG2E;

constexpr size_t MiB = 1u << 20;
constexpr size_t WS_SSQ = 1 * MiB;
constexpr size_t WS_W = 2 * MiB;
constexpr size_t LW_IN = 0, LW_OUT = 9 * MiB / 2, LW_Q = 13 * MiB / 2, LW_KV = 17 * MiB / 2, LW_O = 25 * MiB / 2, LW_UP = 29 * MiB / 2, LW_DN = 45 * MiB / 2, LW_STRIDE = 61 * MiB / 2;
constexpr size_t WS_XB = 64 * MiB;
constexpr size_t WS_U = 96 * MiB;
constexpr size_t WS_MIX = 168 * MiB;
constexpr size_t WS_QX = 96 * MiB, WS_P = 128 * MiB, WS_OX = 168 * MiB;
constexpr size_t WS_H = 96 * MiB;
constexpr size_t WS_KMEM = 224 * MiB;
constexpr size_t WS_VT = 228 * MiB;
constexpr size_t WS_MEMN = 232 * MiB;
constexpr size_t WS_ROT = 234 * MiB;
constexpr size_t WS_VP = 238 * MiB;
constexpr size_t WS_END = 254 * MiB;

constexpr int RING_BYTES = 131072, SCR_OFF = RING_BYTES + 1024, LDS_BYTES = 147456;

DI unsigned pk2(float lo, float hi) { f32x2 v = {lo, hi}; bf16x2_t b = __builtin_convertvector(v, bf16x2_t); return __builtin_bit_cast(unsigned, b); }
DI float bf_lo(unsigned w) { return __uint_as_float(w << 16); }
DI float bf_hi(unsigned w) { return __uint_as_float(w & 0xffff0000u); }
DI float row_rstd(const float* ssq, int row) {
    const f32x4* p = (const f32x4*)(ssq + (size_t)row * 16);
    const f32x4 a = p[0], b = p[1], c = p[2], d = p[3];
    const float s = ((a[0] + a[1]) + (a[2] + a[3])) + ((b[0] + b[1]) + (b[2] + b[3])) + ((c[0] + c[1]) + (c[2] + c[3])) + ((d[0] + d[1]) + (d[2] + d[3]));
    return 1.0f / sqrtf(s * (1.0f / 1024.0f) + EPS);
}

DI void team_barrier_at(unsigned* cnt, unsigned* bar, unsigned gen);

namespace pg8 {
constexpr int BM = 256, BK = 64, HALF = 128, HTB = HALF * BK * 2, NXCD = 8, WGM = 8;
__host__ __device__ __forceinline__ int lds_byte(int r, int c) { const int st = (r >> 4) * 2 + (c >> 5), rr = r & 15, cc = c & 31, ob = rr * 64 + cc * 2; return st * 1024 + (ob ^ (((ob >> 9) & 1) << 5)); }
__host__ __device__ __forceinline__ void stage_rc(int b, int& R, int& C) { const int st = b / 1024, sb = b % 1024, swz = sb ^ (((sb >> 9) & 1) << 5); R = (st >> 1) * 16 + swz / 64; C = (st & 1) * 32 + (swz % 64) / 2; }
__host__ __device__ __forceinline__ int perm32(int rho) { const int n = rho >> 4, i = rho & 15; return 8 * (i >> 2) + 4 * n + (i & 3); }

struct Unit { int pm, pn; };
struct Gemm { const bf16_t* A; const bf16_t* Bt; int K, lda, ldb, nM, nN; int a_div; long a_s1, a_s2, a_s3; int b_div; long b_s1, b_s2, b_s3; };
DI Gemm std_gemm(const bf16_t* A, const bf16_t* Bt, int K, int lda, int ldb, int nM, int nN) { return Gemm{A, Bt, K, lda, ldb, nM, nN, 1, 256L * lda, 0, 0, 1, 0, 0, 256L * ldb}; }
DI const char* abase(const Gemm& g, const Unit& u) { return (const char*)(g.A + (size_t)(u.pm / g.a_div) * g.a_s1 + (size_t)(u.pm % g.a_div) * g.a_s2 + (size_t)u.pn * g.a_s3); }
DI const char* bbase(const Gemm& g, const Unit& u) { return (const char*)(g.Bt + (size_t)(u.pm / g.b_div) * g.b_s1 + (size_t)(u.pm % g.b_div) * g.b_s2 + (size_t)u.pn * g.b_s3); }

struct StaticOrder {
    int nM, nN, nwg, G, c;
    DI void init(int nM_, int nN_, int G_, int c_) { nM = nM_; nN = nN_; nwg = nM * nN; G = G_; c = c_; }
    DI bool next(int i, Unit& u) const {
        const long L = (long)i * G + c; if (L >= nwg) return false;
        int wgid = (int)L; { const int q = nwg / NXCD, r = nwg % NXCD, xcd = wgid % NXCD, off = wgid / NXCD; wgid = (xcd < r ? xcd * (q + 1) : r * (q + 1) + (xcd - r) * q) + off; }
        const int nig = WGM * nN, gid = wgid / nig, fm = gid * WGM, gsz = (nM - fm) < WGM ? (nM - fm) : WGM;
        u.pm = fm + ((wgid % nig) % gsz); u.pn = (wgid % nig) / gsz; return true;
    }
};

typedef f32x4 Acc[2][2][4][2];

template <int ACT> struct EpiScale {
    static constexpr bool PERM = true;
    bf16_t* O; int ldc; const float* ssq; float scale; int pm0 = -1;
    DI void operator()(Acc& acc, const Unit& u, int wr, int wc, int fr, int fq, LAS unsigned char* scr) const {
        const int row0 = u.pm * BM + wr * 64 + fr, col0 = u.pn * BM + wc * 32 + 8 * fq;
        const LAS float* tab = (const LAS float*)(scr + 8192);
#pragma unroll
        for (int ai = 0; ai < 2; ++ai)
#pragma unroll
            for (int m = 0; m < 4; ++m) {
                const int row = row0 + ai * HALF + m * 16;
                const float rs = ssq ? ((u.pm == pm0) ? tab[ai * HALF + wr * 64 + m * 16 + fr] : row_rstd(ssq, row)) * scale : scale;
                bf16_t* rowp = O + (size_t)row * ldc + col0;
#pragma unroll
                for (int bj = 0; bj < 2; ++bj) {
                    f32x4 v0 = acc[ai][bj][m][0] * rs, v1 = acc[ai][bj][m][1] * rs;
                    if (ACT == 1) {
#pragma unroll
                        for (int e = 0; e < 4; ++e) { const float a = fmaxf(v0[e], 0.f), b = fmaxf(v1[e], 0.f); v0[e] = a * a; v1[e] = b * b; }
                    }
                    u32x4 w; w.x = pk2(v0[0], v0[1]); w.y = pk2(v0[2], v0[3]); w.z = pk2(v1[0], v1[1]); w.w = pk2(v1[2], v1[3]);
                    *(u32x4*)(rowp + bj * HALF) = w;
                }
            }
    }
};

struct EpiWin {
    static constexpr bool PERM = true;
    bf16_t* U; const float* ssq; const float* rot; int pm0 = -1; unsigned* war = nullptr; unsigned war_target = 0u; unsigned* barw = nullptr;
    DI void operator()(Acc& acc, const Unit& u, int wr, int wc, int fr, int fq, LAS unsigned char* scr) const {
        const LAS float* tab = (const LAS float*)(scr + 8192);
        if (war) {
            unsigned sp = 0u;
            while (__hip_atomic_load(war, __ATOMIC_RELAXED, __HIP_MEMORY_SCOPE_AGENT) < war_target) {
                __builtin_amdgcn_s_sleep(1);
                if ((++sp & 255u) == 0u) { if (__hip_atomic_load(barw + 128, __ATOMIC_RELAXED, __HIP_MEMORY_SCOPE_AGENT)) break; if (sp > (1u << 18)) { atomicAdd(barw + 128, 1u); break; } }
            }
        }
        const int row0 = u.pm * BM + wr * 64 + fr, col0 = u.pn * BM + wc * 32 + 8 * fq;
        const bool isq = (u.pn == 6) || (u.pn == 7), isk8 = (u.pn == 8);
        const int i0 = 16 * (wc & 1) + 4 * fq;
#pragma unroll
        for (int ai = 0; ai < 2; ++ai)
#pragma unroll
            for (int m = 0; m < 4; ++m) {
                const int row = row0 + ai * HALF + m * 16;
                const float rs = (u.pm == pm0) ? tab[ai * HALF + wr * 64 + m * 16 + fr] : row_rstd(ssq, row);
                bf16_t* rowp = U + (size_t)row * INC + col0;
                f32x4 cs0 = {1.f, 0.f, 1.f, 0.f}, cs1 = {1.f, 0.f, 1.f, 0.f};
                if (isq || isk8) { const f32x4* rp = (const f32x4*)(rot + ((size_t)row * 32 + i0) * 2); cs0 = rp[0]; cs1 = rp[1]; }
#pragma unroll
                for (int bj = 0; bj < 2; ++bj) {
                    f32x4 v0 = acc[ai][bj][m][0] * rs, v1 = acc[ai][bj][m][1] * rs;
                    if (isq || (isk8 && bj == 0)) {
                        const float sc = isq ? QSCALE : 1.0f;
                        f32x4 r0, r1;
                        r0[0] = (v0[0] * cs0[0] - v0[1] * cs0[1]) * sc; r0[1] = (v0[1] * cs0[0] + v0[0] * cs0[1]) * sc;
                        r0[2] = (v0[2] * cs0[2] - v0[3] * cs0[3]) * sc; r0[3] = (v0[3] * cs0[2] + v0[2] * cs0[3]) * sc;
                        r1[0] = (v1[0] * cs1[0] - v1[1] * cs1[1]) * sc; r1[1] = (v1[1] * cs1[0] + v1[0] * cs1[1]) * sc;
                        r1[2] = (v1[2] * cs1[2] - v1[3] * cs1[3]) * sc; r1[3] = (v1[3] * cs1[2] + v1[2] * cs1[3]) * sc;
                        v0 = r0; v1 = r1;
                    }
                    u32x4 w; w.x = pk2(v0[0], v0[1]); w.y = pk2(v0[2], v0[3]); w.z = pk2(v1[0], v1[1]); w.w = pk2(v1[2], v1[3]);
                    *(u32x4*)(rowp + bj * HALF) = w;
                }
            }
    }
};

template <int MODE> struct EpiResid {
    static constexpr bool PERM = true;
    const float* basef; float* out; bf16_t* xb; float* ssq;
    DI void operator()(Acc& acc, const Unit& u, int wr, int wc, int fr, int fq, LAS unsigned char*) const {
        const int row0 = u.pm * BM + wr * 64 + fr, col0 = u.pn * BM + wc * 32 + 8 * fq;
#pragma unroll
        for (int ai = 0; ai < 2; ++ai)
#pragma unroll
            for (int m = 0; m < 4; ++m) {
                const int row = row0 + ai * HALF + m * 16; const size_t off = (size_t)row * D + col0;
                float s = 0.f;
#pragma unroll
                for (int bj = 0; bj < 2; ++bj) {
                    f32x4 b0, b1;
                    if (MODE == 0) { b0 = __builtin_nontemporal_load((const f32x4*)(basef + off + bj * HALF)); b1 = __builtin_nontemporal_load((const f32x4*)(basef + off + bj * HALF + 4)); }
                    else { const u32x4 w = *(const u32x4*)(xb + off + bj * HALF); b0 = (f32x4){bf_lo(w.x), bf_hi(w.x), bf_lo(w.y), bf_hi(w.y)}; b1 = (f32x4){bf_lo(w.z), bf_hi(w.z), bf_lo(w.w), bf_hi(w.w)}; }
                    const f32x4 o0 = b0 + acc[ai][bj][m][0], o1 = b1 + acc[ai][bj][m][1];
                    if (MODE == 2) {
                        *(f32x4*)(out + off + bj * HALF) = o0; *(f32x4*)(out + off + bj * HALF + 4) = o1;
                        s += ((o0[0] * o0[0] + o0[1] * o0[1]) + (o0[2] * o0[2] + o0[3] * o0[3])) + ((o1[0] * o1[0] + o1[1] * o1[1]) + (o1[2] * o1[2] + o1[3] * o1[3]));
                    } else {
                        u32x4 w; w.x = pk2(o0[0], o0[1]); w.y = pk2(o0[2], o0[3]); w.z = pk2(o1[0], o1[1]); w.w = pk2(o1[2], o1[3]);
                        *(u32x4*)(xb + off + bj * HALF) = w;
                        const float r0 = bf_lo(w.x), r1 = bf_hi(w.x), r2 = bf_lo(w.y), r3 = bf_hi(w.y), r4 = bf_lo(w.z), r5 = bf_hi(w.z), r6 = bf_lo(w.w), r7 = bf_hi(w.w);
                        s += ((r0 * r0 + r1 * r1) + (r2 * r2 + r3 * r3)) + ((r4 * r4 + r5 * r5) + (r6 * r6 + r7 * r7));
                    }
                }
                s += __shfl_xor(s, 16); s += __shfl_xor(s, 32);
                if (fq == 0) ssq[(size_t)row * 16 + u.pn * 4 + wc] = s;
            }
    }
};

struct EpiFinal {
    static constexpr bool PERM = true;
    float* out; const bf16_t* xb; float* ssq; const float* fg; unsigned* tcnt; unsigned* barw; unsigned gen;
    DI void operator()(Acc& acc, const Unit& u, int wr, int wc, int fr, int fq, LAS unsigned char*) const {
        const int row0 = u.pm * BM + wr * 64 + fr, col0 = u.pn * BM + wc * 32 + 8 * fq;
#pragma unroll
        for (int ai = 0; ai < 2; ++ai)
#pragma unroll
            for (int m = 0; m < 4; ++m) {
                const int row = row0 + ai * HALF + m * 16; const size_t off = (size_t)row * D + col0;
                float s = 0.f;
#pragma unroll
                for (int bj = 0; bj < 2; ++bj) {
                    const u32x4 w = *(const u32x4*)(xb + off + bj * HALF);
                    const f32x4 o0 = (f32x4){bf_lo(w.x), bf_hi(w.x), bf_lo(w.y), bf_hi(w.y)} + acc[ai][bj][m][0], o1 = (f32x4){bf_lo(w.z), bf_hi(w.z), bf_lo(w.w), bf_hi(w.w)} + acc[ai][bj][m][1];
                    acc[ai][bj][m][0] = o0; acc[ai][bj][m][1] = o1;
                    s += ((o0[0] * o0[0] + o0[1] * o0[1]) + (o0[2] * o0[2] + o0[3] * o0[3])) + ((o1[0] * o1[0] + o1[1] * o1[1]) + (o1[2] * o1[2] + o1[3] * o1[3]));
                }
                s += __shfl_xor(s, 16); s += __shfl_xor(s, 32);
                if (fq == 0) ssq[(size_t)row * 16 + u.pn * 4 + wc] = s;
            }
        team_barrier_at(tcnt, barw, gen);
        f32x4 gv[2][2];
#pragma unroll
        for (int bj = 0; bj < 2; ++bj) { gv[bj][0] = *(const f32x4*)(fg + col0 + bj * HALF); gv[bj][1] = *(const f32x4*)(fg + col0 + bj * HALF + 4); }
#pragma unroll
        for (int ai = 0; ai < 2; ++ai)
#pragma unroll
            for (int m = 0; m < 4; ++m) {
                const int row = row0 + ai * HALF + m * 16; const size_t off = (size_t)row * D + col0;
                const float rs = row_rstd(ssq, row);
#pragma unroll
                for (int bj = 0; bj < 2; ++bj) {
                    __builtin_nontemporal_store(acc[ai][bj][m][0] * rs * gv[bj][0], (f32x4*)(out + off + bj * HALF));
                    __builtin_nontemporal_store(acc[ai][bj][m][1] * rs * gv[bj][1], (f32x4*)(out + off + bj * HALF + 4));
                }
            }
    }
};

struct EpiSoftmax {
    static constexpr bool PERM = true;
    bf16_t* P; int ldc; const float* ssq; float scale; int pm0;
    DI void operator()(Acc& acc, const Unit& u, int wr, int wc, int fr, int fq, LAS unsigned char* scr) const {
        LAS f32x2* X = (LAS f32x2*)scr;
        const LAS float* tab = (const LAS float*)(scr + 8192);
        float mw[2][4];
#pragma unroll
        for (int ai = 0; ai < 2; ++ai)
#pragma unroll
            for (int m = 0; m < 4; ++m) {
                const float rs = ((u.pm == pm0) ? tab[ai * HALF + wr * 64 + m * 16 + fr] : row_rstd(ssq, u.pm * BM + ai * HALF + wr * 64 + m * 16 + fr)) * scale;
#pragma unroll
                for (int bj = 0; bj < 2; ++bj)
#pragma unroll
                    for (int n = 0; n < 2; ++n) acc[ai][bj][m][n] = acc[ai][bj][m][n] * rs;
                float mx = -INFINITY;
#pragma unroll
                for (int bj = 0; bj < 2; ++bj)
#pragma unroll
                    for (int n = 0; n < 2; ++n)
#pragma unroll
                        for (int e = 0; e < 4; ++e) mx = fmaxf(mx, acc[ai][bj][m][n][e]);
                mx = fmaxf(mx, __shfl_xor(mx, 16)); mx = fmaxf(mx, __shfl_xor(mx, 32));
                float s = 0.f;
#pragma unroll
                for (int bj = 0; bj < 2; ++bj)
#pragma unroll
                    for (int n = 0; n < 2; ++n)
#pragma unroll
                        for (int e = 0; e < 4; ++e) { const float p = __builtin_amdgcn_exp2f(acc[ai][bj][m][n][e] - mx); acc[ai][bj][m][n][e] = p; s += p; }
                s += __shfl_xor(s, 16); s += __shfl_xor(s, 32);
                mw[ai][m] = mx;
                if (fq == 0) X[(ai * HALF + wr * 64 + m * 16 + fr) * 4 + wc] = (f32x2){mx, s};
            }
        asm volatile("s_waitcnt lgkmcnt(0)" ::: "memory"); __builtin_amdgcn_s_barrier(); asm volatile("" ::: "memory");
        const int row0 = u.pm * BM + wr * 64 + fr, col0 = u.pn * BM + wc * 32 + 8 * fq;
#pragma unroll
        for (int ai = 0; ai < 2; ++ai)
#pragma unroll
            for (int m = 0; m < 4; ++m) {
                const int rl = ai * HALF + wr * 64 + m * 16 + fr;
                const f32x2 a = X[rl * 4 + 0], b = X[rl * 4 + 1], c = X[rl * 4 + 2], d = X[rl * 4 + 3];
                const float M = fmaxf(fmaxf(a.x, b.x), fmaxf(c.x, d.x));
                const float tot = a.y * __builtin_amdgcn_exp2f(a.x - M) + b.y * __builtin_amdgcn_exp2f(b.x - M) + c.y * __builtin_amdgcn_exp2f(c.x - M) + d.y * __builtin_amdgcn_exp2f(d.x - M);
                const float sc = __builtin_amdgcn_exp2f(mw[ai][m] - M) / tot;
                bf16_t* rowp = P + (size_t)(row0 + ai * HALF + m * 16) * ldc + col0;
#pragma unroll
                for (int bj = 0; bj < 2; ++bj) {
                    const f32x4 v0 = acc[ai][bj][m][0] * sc, v1 = acc[ai][bj][m][1] * sc;
                    u32x4 w; w.x = pk2(v0[0], v0[1]); w.y = pk2(v0[2], v0[3]); w.z = pk2(v1[0], v1[1]); w.w = pk2(v1[2], v1[3]);
                    *(u32x4*)(rowp + bj * HALF) = w;
                }
            }
        asm volatile("s_waitcnt lgkmcnt(0)" ::: "memory"); __builtin_amdgcn_s_barrier(); asm volatile("" ::: "memory");
    }
};

template <class Epi>
DI void gemm_phase(LAS unsigned char* lds, LAS unsigned char* scr, const Gemm g, const StaticOrder& S, const Epi& E) {
    int tid = threadIdx.x; asm volatile("" : "+v"(tid));
    const int wid = __builtin_amdgcn_readfirstlane(tid >> 6), lane = tid & 63, wr = wid >> 2, wc = wid & 3, fr = lane & 15, fq = lane >> 4;
    const int nt = g.K / BK;
    unsigned voffA[2], voffB[2];
#pragma unroll
    for (int i = 0; i < 2; ++i) { int R, C; stage_rc(tid * 16 + i * 8192, R, C); const int Rb = Epi::PERM ? ((R & ~31) + perm32(R & 31)) : R;
        voffA[i] = (unsigned)(R * g.lda + C) * 2u; voffB[i] = (unsigned)(Rb * g.ldb + C) * 2u; }
    const size_t kstep = (size_t)(BK * 2);
    const size_t hsA = (size_t)HALF * g.lda * 2, hsB = (size_t)HALF * g.ldb * 2;
    const unsigned ldsw = (unsigned)wid * 1024u;
    const int aoff = lds_byte(wr * 64 + fr, fq * 8), boff = lds_byte(wc * 32 + fr, fq * 8);
#define PG8_SA(b, h) (((b) * 2 + (h)) * HTB)
#define PG8_SB(b, h) ((4 + (b) * 2 + (h)) * HTB)
#define PG8_STAGE(bufoff, gbase, voff) do { _Pragma("unroll") for (int _i = 0; _i < 2; ++_i) \
        __builtin_amdgcn_global_load_lds((const unsigned*)((const char*)(gbase) + (voff)[_i]), (LAS unsigned*)(lds + (bufoff) + ldsw + _i * 8192), 16, 0, 0); } while (0)
#define PG8_LDA(dst, b, h) do { _Pragma("unroll") for (int m = 0; m < 4; ++m) _Pragma("unroll") for (int k = 0; k < 2; ++k) dst[m][k] = *(const LAS bf16x8*)(lds + PG8_SA(b, h) + aoff + m * 2048 + k * 1024); } while (0)
#define PG8_LDB(dst, b, h) do { _Pragma("unroll") for (int n = 0; n < 2; ++n) _Pragma("unroll") for (int k = 0; k < 2; ++k) dst[n][k] = *(const LAS bf16x8*)(lds + PG8_SB(b, h) + boff + n * 2048 + k * 1024); } while (0)
#define PG8_MMA(ai, bj, At, Bt) do { __builtin_amdgcn_s_setprio(1); _Pragma("unroll") for (int m = 0; m < 4; ++m) _Pragma("unroll") for (int n = 0; n < 2; ++n) _Pragma("unroll") for (int k = 0; k < 2; ++k) \
        acc[ai][bj][m][n] = __builtin_amdgcn_mfma_f32_16x16x32_bf16(Bt[n][k], At[m][k], acc[ai][bj][m][n], 0, 0, 0); __builtin_amdgcn_s_setprio(0); } while (0)
#define PG8_WAIT_V(n) asm volatile("s_waitcnt vmcnt(" #n ")" ::: "memory")
#define PG8_WAIT_L(n) asm volatile("s_waitcnt lgkmcnt(" #n ")" ::: "memory")
#define PG8_BAR __builtin_amdgcn_s_barrier()
#define PG8_SCHED __builtin_amdgcn_sched_barrier(0)
    Unit cur, nxt; int ui = 0;
    if (!S.next(0, cur)) return;
    Acc acc;
#pragma unroll
    for (int a = 0; a < 2; ++a)
#pragma unroll
        for (int b = 0; b < 2; ++b)
#pragma unroll
            for (int m = 0; m < 4; ++m)
#pragma unroll
                for (int n = 0; n < 2; ++n) acc[a][b][m][n] = (f32x4){0.f, 0.f, 0.f, 0.f};
    bf16x8 At[4][2], B0[2][2], B1[2][2];
    const char* cA = abase(g, cur); const char* cB = bbase(g, cur);
    PG8_STAGE(PG8_SB(0, 0), cB, voffB); PG8_STAGE(PG8_SB(0, 1), cB + hsB, voffB); PG8_STAGE(PG8_SA(0, 0), cA, voffA); PG8_STAGE(PG8_SA(0, 1), cA + hsA, voffA);
    if (wr == 1) PG8_BAR;
    PG8_WAIT_V(2); PG8_BAR;
    PG8_STAGE(PG8_SB(1, 0), cB + kstep, voffB); PG8_STAGE(PG8_SA(1, 0), cA + kstep, voffA); PG8_STAGE(PG8_SB(1, 1), cB + hsB + kstep, voffB);
    PG8_WAIT_V(6); PG8_BAR;
    for (;;) {
        const bool has_next = S.next(ui + 1, nxt);
        const char* nA = has_next ? abase(g, nxt) : cA; const char* nB = has_next ? bbase(g, nxt) : cB;
        for (int t = 0; t < nt; t += 2) {
            const bool last = (t == nt - 2);
            const char* a1 = cA + (size_t)(t + 1) * kstep;
            const char* a2 = last ? nA : cA + (size_t)(t + 2) * kstep; const char* b2 = last ? nB : cB + (size_t)(t + 2) * kstep;
            const char* a3 = a2 + kstep; const char* b3 = b2 + kstep;
            PG8_LDB(B0, 0, 0); PG8_LDB(B1, 0, 1); PG8_SCHED; PG8_LDA(At, 0, 0); PG8_STAGE(PG8_SA(1, 1), a1 + hsA, voffA);
            PG8_WAIT_V(8); PG8_WAIT_L(0); PG8_BAR; PG8_MMA(0, 0, At, B0); PG8_MMA(0, 1, At, B1); PG8_BAR; PG8_SCHED;
            PG8_LDA(At, 0, 1); PG8_STAGE(PG8_SB(0, 0), b2, voffB); PG8_STAGE(PG8_SB(0, 1), b2 + hsB, voffB); PG8_STAGE(PG8_SA(0, 0), a2, voffA);
            PG8_WAIT_V(8); PG8_WAIT_L(0); PG8_BAR; PG8_MMA(1, 0, At, B0); PG8_MMA(1, 1, At, B1); PG8_BAR; PG8_SCHED;
            PG8_LDB(B0, 1, 0); PG8_LDB(B1, 1, 1); PG8_SCHED; PG8_LDA(At, 1, 0); PG8_STAGE(PG8_SA(0, 1), a2 + hsA, voffA);
            PG8_WAIT_V(8); PG8_WAIT_L(0); PG8_BAR; PG8_MMA(0, 0, At, B0); PG8_MMA(0, 1, At, B1); PG8_BAR; PG8_SCHED;
            PG8_LDA(At, 1, 1); PG8_STAGE(PG8_SB(1, 0), b3, voffB); PG8_STAGE(PG8_SB(1, 1), b3 + hsB, voffB); PG8_STAGE(PG8_SA(1, 0), a3, voffA);
            PG8_WAIT_V(8); PG8_WAIT_L(0); PG8_BAR; PG8_MMA(1, 0, At, B0); PG8_MMA(1, 1, At, B1); PG8_BAR; PG8_SCHED;
        }
        if (wr == 0) PG8_BAR;
        E(acc, cur, wr, wc, fr, fq, scr);
        if (!has_next) break;
#pragma unroll
        for (int a = 0; a < 2; ++a)
#pragma unroll
            for (int b = 0; b < 2; ++b)
#pragma unroll
                for (int m = 0; m < 4; ++m)
#pragma unroll
                    for (int n = 0; n < 2; ++n) acc[a][b][m][n] = (f32x4){0.f, 0.f, 0.f, 0.f};
        cur = nxt; cA = nA; cB = nB; ++ui;
        if (wr == 1) PG8_BAR;
    }
    PG8_WAIT_V(0);
    PG8_BAR;
#undef PG8_SA
#undef PG8_SB
#undef PG8_STAGE
#undef PG8_LDA
#undef PG8_LDB
#undef PG8_MMA
#undef PG8_WAIT_V
#undef PG8_WAIT_L
#undef PG8_BAR
#undef PG8_SCHED
}
}

DI float wave_sum(float v) {
#pragma unroll
    for (int o = 1; o < 64; o <<= 1) v += __shfl_xor(v, o);
    return v;
}
struct TItem { const float* W; bf16_t* WT; const float* g; const float* g2; int K, N, rot_lo, rot_hi, item; };
DI void p0_item_load(const TItem& t, float (&v)[32], int lane) {
    const int nblk = t.N / 32, kb = t.item / nblk, nb = t.item % nblk, k0 = 64 * kb, n0 = 32 * nb;
    const int nc = lane & 7;
    const bool rot = n0 >= t.rot_lo && n0 < t.rot_hi;
    const int c0 = rot ? (n0 & ~63) + 32 * (nc >> 2) + ((n0 & 63) >> 1) + 4 * (nc & 3) : n0 + 4 * nc;
#pragma unroll
    for (int i = 0; i < 8; ++i) {
        const int k = k0 + 8 * i + (lane >> 3);
        float gv = 1.0f;
        if (t.g) gv = (t.g2 && k >= 512) ? t.g2[k - 512] : t.g[k];
        const f32x4 w = __builtin_nontemporal_load((const f32x4*)(t.W + (size_t)k * t.N + c0));
        v[4 * i + 0] = w[0] * gv; v[4 * i + 1] = w[1] * gv; v[4 * i + 2] = w[2] * gv; v[4 * i + 3] = w[3] * gv;
    }
}
DI void p0_item_finish(const TItem& t, const float (&v)[32], LAS float* scr, int lane) {
    const int nblk = t.N / 32, kb = t.item / nblk, nb = t.item % nblk, k0 = 64 * kb, n0 = 32 * nb;
    const int nc = lane & 7;
    const bool rot = n0 >= t.rot_lo && n0 < t.rot_hi;
    const int d0 = rot ? 8 * (nc & 3) + (nc >> 2) : 4 * nc, ds = rot ? 2 : 1;
#pragma unroll
    for (int i = 0; i < 8; ++i)
#pragma unroll
        for (int e = 0; e < 4; ++e) scr[(8 * i + (lane >> 3)) * 33 + d0 + e * ds] = v[4 * i + e];
    asm volatile("s_waitcnt lgkmcnt(0)" ::: "memory");
    const int c = lane & 7;
#pragma unroll
    for (int j = 0; j < 4; ++j) { const int n = (lane >> 3) + 8 * j; const LAS float* s = scr + (8 * c) * 33 + n;
        u32x4 o; o.x = pk2(s[0 * 33], s[1 * 33]); o.y = pk2(s[2 * 33], s[3 * 33]); o.z = pk2(s[4 * 33], s[5 * 33]); o.w = pk2(s[6 * 33], s[7 * 33]);
        *(u32x4*)(t.WT + (size_t)(n0 + n) * t.K + k0 + 8 * c) = o; }
    asm volatile("s_waitcnt lgkmcnt(0)" ::: "memory");
}

constexpr int SW_KOFF = 0, SW_KSTR = 272, SW_VOFF = 192 * 272, SW_VSTR = 320, SW_XOFF = SW_VOFF + 192 * 320;
static_assert(SW_XOFF + 2 * 32 * 8 * 4 <= RING_BYTES, "swa LDS");
DI int crow(int r, int hi) { return (r & 3) + 8 * (r >> 2) + 4 * hi; }
typedef short v4i16_t __attribute__((ext_vector_type(4)));
DI s16x4 vtr(LAS unsigned char* p) { return __builtin_bit_cast(s16x4, __builtin_amdgcn_ds_read_tr16_b64_v4i16((LAS v4i16_t*)p)); }

template <bool EDGE> DI void swa_conv_unit(int unit, const bf16_t* U, bf16_t* MIX, const float* convw, const float* sinks, LAS unsigned char* lds) {
    int tid = threadIdx.x; asm volatile("" : "+v"(tid));
    const int lane = tid & 63, wid = __builtin_amdgcn_readfirstlane(tid >> 6);
    const int b = unit >> 6, qt = unit & 63, q0s = qt * 64, tok0 = b * SEQ + q0s;
#pragma unroll
    for (int it = 0; it < 6; ++it) {
        const int id = it * 512 + tid, key = id >> 4, ch = id & 15;
        u32x4 kv = {0u, 0u, 0u, 0u}, vv = {0u, 0u, 0u, 0u};
        if (!EDGE || q0s - 128 + key >= 0) { const bf16_t* rowp = U + (size_t)(tok0 - 128 + key) * INC; kv = *(const u32x4*)(rowp + 2048 + ch * 8); vv = *(const u32x4*)(rowp + 2176 + ch * 8); }
        *(LAS u32x4*)(lds + SW_KOFF + key * SW_KSTR + ch * 16) = kv;
        *(LAS u32x4*)(lds + SW_VOFF + key * SW_VSTR + ch * 16) = vv;
    }
    {
        const int c0 = lane * 8, t0 = tok0 + 8 * wid, s0 = q0s + 8 * wid;
        float w0[8], w1[8], w2[8], p2[8], p1[8];
#pragma unroll
        for (int e = 0; e < 8; ++e) { w0[e] = convw[c0 + e]; w1[e] = convw[512 + c0 + e]; w2[e] = convw[1024 + c0 + e]; p2[e] = 0.f; p1[e] = 0.f; }
        if (s0 >= 2) {
            const bf16_t* r2 = U + (size_t)(t0 - 2) * INC; const bf16_t* r1 = U + (size_t)(t0 - 1) * INC;
            const u32x4 gc2 = *(const u32x4*)(r2 + 512 + c0), xc2 = *(const u32x4*)(r2 + 1024 + c0), gc1 = *(const u32x4*)(r1 + 512 + c0), xc1 = *(const u32x4*)(r1 + 1024 + c0);
#pragma unroll
            for (int e = 0; e < 4; ++e) { p2[2 * e] = bf_lo(gc2[e]) * bf_lo(xc2[e]); p2[2 * e + 1] = bf_hi(gc2[e]) * bf_hi(xc2[e]); p1[2 * e] = bf_lo(gc1[e]) * bf_lo(xc1[e]); p1[2 * e + 1] = bf_hi(gc1[e]) * bf_hi(xc1[e]); }
        }
#pragma unroll 2
        for (int j = 0; j < 8; ++j) {
            const bf16_t* r = U + (size_t)(t0 + j) * INC;
            const u32x4 gb = *(const u32x4*)(r + c0), gc = *(const u32x4*)(r + 512 + c0), xc = *(const u32x4*)(r + 1024 + c0);
            float pc[8], o[8]; float ss = 0.f;
#pragma unroll
            for (int e = 0; e < 4; ++e) { pc[2 * e] = bf_lo(gc[e]) * bf_lo(xc[e]); pc[2 * e + 1] = bf_hi(gc[e]) * bf_hi(xc[e]); }
#pragma unroll
            for (int e = 0; e < 8; ++e) {
                const float cv = w0[e] * p2[e] + w1[e] * p1[e] + w2[e] * pc[e];
                const float gbv = (e & 1) ? bf_hi(gb[e >> 1]) : bf_lo(gb[e >> 1]);
                o[e] = gbv * cv; ss += o[e] * o[e];
            }
            ss = wave_sum(ss);
            const float rs = 1.0f / sqrtf(ss * (1.0f / 512.0f) + EPS);
            u32x4 w; w.x = pk2(o[0] * rs, o[1] * rs); w.y = pk2(o[2] * rs, o[3] * rs); w.z = pk2(o[4] * rs, o[5] * rs); w.w = pk2(o[6] * rs, o[7] * rs);
            *(u32x4*)(MIX + (size_t)(t0 + j) * D + c0) = w;
#pragma unroll
            for (int e = 0; e < 8; ++e) { p2[e] = p1[e]; p1[e] = pc[e]; }
        }
    }
    const int h = wid, kvh = h >> 2, r32 = lane & 31, hi = lane >> 5;
    const float sink2 = sinks[h] * LOG2E;
    __syncthreads();
    LAS float* X = (LAS float*)(lds + SW_XOFF);
    const int qq = (lane & 15) >> 2, pp = lane & 3, gg = (lane >> 4) & 1;
#pragma unroll 1
    for (int qs = 0; qs < 2; ++qs) {
        bf16x8 qf[4];
#pragma unroll
        for (int kb = 0; kb < 4; ++kb) qf[kb] = *(const bf16x8*)(U + (size_t)(tok0 + 32 * qs + r32) * INC + 1536 + h * 64 + 16 * kb + 8 * hi);
        f32x16 st[5];
#pragma unroll
        for (int kt = 0; kt < 5; ++kt) {
#pragma unroll
            for (int r = 0; r < 16; ++r) st[kt][r] = 0.f;
#pragma unroll
            for (int kb = 0; kb < 4; ++kb) {
                const bf16x8 kf = *(const LAS bf16x8*)(lds + SW_KOFF + (32 * (qs + kt) + r32) * SW_KSTR + (kvh * 64 + 16 * kb + 8 * hi) * 2);
                st[kt] = __builtin_amdgcn_mfma_f32_32x32x16_bf16(kf, qf[kb], st[kt], 0, 0, 0);
            }
        }
        float mx = sink2;
        const int kpos0 = q0s + 32 * qs - 128;
        if constexpr (EDGE) {
#pragma unroll
            for (int kt = 0; kt < 5; ++kt)
#pragma unroll
                for (int r = 0; r < 16; ++r) {
                    const int kr = 32 * kt + crow(r, hi);
                    const bool valid = (kr > r32) && (kr <= r32 + 128) && (kpos0 + kr >= 0);
                    const float v = valid ? st[kt][r] : -INFINITY;
                    st[kt][r] = v; mx = fmaxf(mx, v);
                }
        } else {
#pragma unroll
            for (int r = 0; r < 16; ++r) { const float v = (crow(r, hi) > r32) ? st[0][r] : st[4][r]; st[0][r] = v; mx = fmaxf(mx, v); }
#pragma unroll
            for (int kt = 1; kt < 4; ++kt)
#pragma unroll
                for (int r = 0; r < 16; ++r) mx = fmaxf(mx, st[kt][r]);
        }
        mx = fmaxf(mx, __shfl_xor(mx, 32));
        float sum = 0.f;
        if constexpr (EDGE) {
#pragma unroll
            for (int kt = 0; kt < 5; ++kt)
#pragma unroll
                for (int r = 0; r < 16; ++r) { const float p = __builtin_amdgcn_exp2f(st[kt][r] - mx); st[kt][r] = p; sum += p; }
        } else {
            f32x16 acc16;
#pragma unroll
            for (int r = 0; r < 16; ++r) acc16[r] = 0.f;
#pragma unroll
            for (int kt = 0; kt < 4; ++kt) {
                f32x16 d = st[kt] - mx;
#pragma unroll
                for (int r = 0; r < 16; ++r) d[r] = __builtin_amdgcn_exp2f(d[r]);
                acc16 = acc16 + d; st[kt] = d;
            }
#pragma unroll
            for (int r = 0; r < 16; ++r) { const bool t0 = crow(r, hi) > r32; const float e = st[0][r]; st[0][r] = t0 ? e : 0.f; st[4][r] = t0 ? 0.f : e; }
            sum = ((acc16[0] + acc16[1]) + (acc16[2] + acc16[3])) + ((acc16[4] + acc16[5]) + (acc16[6] + acc16[7])) + ((acc16[8] + acc16[9]) + (acc16[10] + acc16[11])) + ((acc16[12] + acc16[13]) + (acc16[14] + acc16[15]));
        }
        sum += __shfl_xor(sum, 32);
        sum += __builtin_amdgcn_exp2f(sink2 - mx);
        const float inv = 1.0f / sum;
        f32x16 o[2];
#pragma unroll
        for (int r = 0; r < 16; ++r) { o[0][r] = 0.f; o[1][r] = 0.f; }
#pragma unroll
        for (int kt = 0; kt < 5; ++kt)
#pragma unroll
            for (int s = 0; s < 2; ++s) {
                u32x4 pw; pw.x = pk2(st[kt][8 * s + 0], st[kt][8 * s + 1]); pw.y = pk2(st[kt][8 * s + 2], st[kt][8 * s + 3]); pw.z = pk2(st[kt][8 * s + 4], st[kt][8 * s + 5]); pw.w = pk2(st[kt][8 * s + 6], st[kt][8 * s + 7]);
                const bf16x8 pf = __builtin_bit_cast(bf16x8, pw);
#pragma unroll
                for (int dt = 0; dt < 2; ++dt) {
                    LAS unsigned char* vb = lds + SW_VOFF + (32 * (qs + kt) + 16 * s + 4 * hi + qq) * SW_VSTR + (kvh * 64 + 32 * dt + 16 * gg) * 2 + 8 * pp;
                    const s16x4 lo = vtr(vb), hi4 = vtr(vb + 8 * SW_VSTR);
                    const bf16x8 vf = __builtin_shufflevector(lo, hi4, 0, 1, 2, 3, 4, 5, 6, 7);
                    o[dt] = __builtin_amdgcn_mfma_f32_32x32x16_bf16(vf, pf, o[dt], 0, 0, 0);
                }
            }
        float ss = 0.f;
#pragma unroll
        for (int dt = 0; dt < 2; ++dt)
#pragma unroll
            for (int r = 0; r < 16; ++r) { o[dt][r] *= inv; ss += o[dt][r] * o[dt][r]; }
        ss += __shfl_xor(ss, 32);
        if (hi == 0) X[(qs * 32 + r32) * 8 + h] = ss;
        __syncthreads();
        const f32x4 xa = *(const LAS f32x4*)(X + (qs * 32 + r32) * 8), xb4 = *(const LAS f32x4*)(X + (qs * 32 + r32) * 8 + 4);
        const float tot = ((xa[0] + xa[1]) + (xa[2] + xa[3])) + ((xb4[0] + xb4[1]) + (xb4[2] + xb4[3]));
        const float rs = 1.0f / sqrtf(tot * (1.0f / 512.0f) + EPS);
        bf16_t* orow = MIX + (size_t)(tok0 + 32 * qs + r32) * D + 512 + h * 64 + 4 * hi;
#pragma unroll
        for (int dt = 0; dt < 2; ++dt)
#pragma unroll
            for (int g4 = 0; g4 < 4; ++g4) {
                u32x2 w; w.x = pk2(o[dt][4 * g4 + 0] * rs, o[dt][4 * g4 + 1] * rs); w.y = pk2(o[dt][4 * g4 + 2] * rs, o[dt][4 * g4 + 3] * rs);
                *(u32x2*)(orow + 32 * dt + 8 * g4) = w;
            }
    }
    __syncthreads();
}

#define XB_TMO      128
#define XB_XCNT(j)  (256  + 64 * (j))
#define XB_XSUB(j)  (1280 + 64 * (j))
#define XB_XGEN(j)  (2304 + 64 * (j))
#define XB_TOP      3328
#define XB_TOPGEN   3392
#define XCD_BAR_WORDS 3456
#define XB_SPIN_CAP (1u << 18)
DI unsigned xb_ld(unsigned* p)              { return __hip_atomic_load(p, __ATOMIC_RELAXED, __HIP_MEMORY_SCOPE_AGENT); }
DI unsigned xb_add(unsigned* p, unsigned v) { return __hip_atomic_fetch_add(p, v, __ATOMIC_RELAXED, __HIP_MEMORY_SCOPE_AGENT); }
DI unsigned xb_xcc_id() { return (unsigned)__builtin_amdgcn_s_getreg((3 << 11) | 20) & 0xFu; }
#define XB_SPIN(cond, bar) do { unsigned _sp = 0; while (cond) { __builtin_amdgcn_s_sleep(1); \
    if ((++_sp & 255u) == 0u) { if (xb_ld(&(bar)[XB_TMO])) break; if (_sp > XB_SPIN_CAP) { atomicAdd(&(bar)[XB_TMO], 1u); break; } } } } while (0)
struct XcdBarrier { unsigned* bar; unsigned x; volatile LAS unsigned* st; };
DI XcdBarrier xcd_barrier_post(unsigned* bar, volatile LAS unsigned* st) {
    XcdBarrier b; b.bar = bar; b.x = xb_xcc_id(); b.st = st;
    if (threadIdx.x == 0) st[4] = xb_add(&bar[XB_XCNT(b.x)], 1u);
    return b;
}
DI void team_barrier_at(unsigned* cnt, unsigned* bar, unsigned gen) {
    asm volatile("s_waitcnt vmcnt(0)" ::: "memory");
    __syncthreads();
    if (threadIdx.x == 0) {
        __builtin_amdgcn_s_waitcnt(0);
        (void)xb_add(cnt, 1u);
        const unsigned target = 4u * (gen + 1u);
        XB_SPIN(xb_ld(cnt) < target, bar);
        __builtin_amdgcn_fence(__ATOMIC_ACQUIRE, "agent");
        asm volatile("s_waitcnt vmcnt(0)" ::: "memory");
    }
    __syncthreads();
}
DI void team_barrier(unsigned* cnt, unsigned* bar, unsigned& gen) { team_barrier_at(cnt, bar, gen); ++gen; }
DI void guard_wait(unsigned* w, unsigned target, unsigned* bar) {
    if (threadIdx.x == 0) { XB_SPIN(xb_ld(w) < target, bar); }
    __syncthreads();
}
DI void xcd_barrier_complete(unsigned* bar, unsigned x, unsigned& nloc, unsigned& nx) {
    const unsigned G = gridDim.x * gridDim.y * gridDim.z;
    unsigned sum, cnt, mine, sp = 0u;
    for (;;) {
        sum = 0u; cnt = 0u; mine = 0u;
#pragma unroll
        for (unsigned j = 0; j < 16; ++j) { const unsigned c = xb_ld(&bar[XB_XCNT(j)]); sum += c; cnt += (c > 0u) ? 1u : 0u; mine = (j == x) ? c : mine; }
        if (sum == G) break;
        __builtin_amdgcn_s_sleep(1);
        if ((++sp & 255u) == 0u) { if (xb_ld(&bar[XB_TMO])) break; if (sp > XB_SPIN_CAP) { atomicAdd(&bar[XB_TMO], 1u); break; } }
    }
    nloc = mine > 0u ? mine : 1u; nx = cnt > 0u ? cnt : 1u;
}
DI void xcd_barrier(const XcdBarrier& b) {
    asm volatile("s_waitcnt vmcnt(0)" ::: "memory");
    __syncthreads();
    if (threadIdx.x == 0) {
        unsigned* bar = b.bar;
        __builtin_amdgcn_s_waitcnt(0);
        unsigned nloc = b.st[0], nx = b.st[1];
        if (nloc == 0u) { xcd_barrier_complete(bar, b.x, nloc, nx); b.st[0] = nloc; b.st[1] = nx; }
        const unsigned old = xb_add(&bar[XB_XSUB(b.x)], 1u);
        const unsigned gen = old / nloc;
        if (old + 1u == (gen + 1u) * nloc) {
            __builtin_amdgcn_fence(__ATOMIC_RELEASE, "agent");
            asm volatile("s_waitcnt vmcnt(0)" ::: "memory");
            const unsigned og = xb_add(&bar[XB_TOP], 1u);
            const unsigned tg = og / nx;
            if (og + 1u == (tg + 1u) * nx) xb_add(&bar[XB_TOPGEN], 1u);
            else XB_SPIN(xb_ld(&bar[XB_TOPGEN]) == tg, bar);
            __builtin_amdgcn_fence(__ATOMIC_ACQUIRE, "agent");
            xb_add(&bar[XB_XGEN(b.x)], 1u);
            asm volatile("s_waitcnt vmcnt(0)" ::: "memory");
        } else {
            XB_SPIN(xb_ld(&bar[XB_XGEN(b.x)]) == gen, bar);
            __builtin_amdgcn_fence(__ATOMIC_ACQUIRE, "agent");
            asm volatile("s_waitcnt vmcnt(0)" ::: "memory");
        }
    }
    __syncthreads();
}

DI int fill_rstd_table(const pg8::StaticOrder& S, const float* ssq, LAS unsigned char* scr) {
    pg8::Unit u0; const bool any = S.next(0, u0);
    int tid = threadIdx.x; asm volatile("" : "+v"(tid));
    if (any && tid < 256) ((LAS float*)(scr + 8192))[tid] = row_rstd(ssq, u0.pm * 256 + tid);
    __syncthreads();
    return any ? u0.pm : -1;
}

struct Args { const void* in[19]; float* out; unsigned char* ws; int ph_lo, ph_hi; };
constexpr int N_PHASES = 20;

__global__ void __launch_bounds__(512, 2) mk_fwd(Args args) {
    extern __shared__ __attribute__((aligned(16))) unsigned char lds_raw[];
    LAS unsigned char* lds = (LAS unsigned char*)lds_raw;
    LAS unsigned char* scr = lds + SCR_OFF;
    const int tid = threadIdx.x, lane = tid & 63, wid = __builtin_amdgcn_readfirstlane(tid >> 6);
    const int G = gridDim.x, bx = blockIdx.x;
    const int vcu = (G % 8 == 0) ? (bx % 8) * (G / 8) + bx / 8 : bx;
    const int gw = vcu * 8 + wid, NGW = G * 8;
    const int lo = args.ph_lo, hi = args.ph_hi;
#define IN(k) (lo <= (k) && (k) < hi)
#define SEAM(k) do { if (IN(k) && IN((k) + 1)) { xcd_barrier(bar); } } while (0)
#define TSEAM(k) do { if (IN(k) && IN((k) + 1)) { if (fast) team_barrier(tcnt, bar.bar, tgen); else xcd_barrier(bar); } } while (0)
    volatile LAS unsigned* MISC = (volatile LAS unsigned*)(lds + RING_BYTES);
    if (tid < 64) MISC[tid] = 0u;
    __syncthreads();
    XcdBarrier bar; bar.bar = (unsigned*)args.ws; bar.x = 0; bar.st = MISC + 8;
    if (hi - lo > 1) bar = xcd_barrier_post((unsigned*)args.ws, MISC + 8);

    const float* x_in = (const float*)args.in[0];
    const float* mem = (const float*)args.in[1];
    const int* positions = (const int*)args.in[2];
    const float* norm_mix_g = (const float*)args.in[3];
    const float* w_in = (const float*)args.in[4];
    const float* conv_w = (const float*)args.in[5];
    const float* sinks = (const float*)args.in[6];
    const float* gnorm_conv_g = (const float*)args.in[7];
    const float* gnorm_attn_g = (const float*)args.in[8];
    const float* w_out = (const float*)args.in[9];
    const float* norm_x_g = (const float*)args.in[10];
    const float* norm_mem_g = (const float*)args.in[11];
    const float* wx_q = (const float*)args.in[12];
    const float* wx_kv = (const float*)args.in[13];
    const float* wx_o = (const float*)args.in[14];
    const float* norm_mlp_g = (const float*)args.in[15];
    const float* w_up = (const float*)args.in[16];
    const float* w_down = (const float*)args.in[17];
    const float* final_g = (const float*)args.in[18];
    float* out = args.out;
    unsigned char* ws = args.ws;
    float* SSQ = (float*)(ws + WS_SSQ);
    bf16_t* XB = (bf16_t*)(ws + WS_XB);
    bf16_t* U = (bf16_t*)(ws + WS_U);
    bf16_t* MIX = (bf16_t*)(ws + WS_MIX);
    bf16_t* QX = (bf16_t*)out;
    bf16_t* PB = (bf16_t*)out;
    bf16_t* OX = (bf16_t*)out;
    bf16_t* HB = (bf16_t*)(ws + WS_H);
    bf16_t* MEMN = (bf16_t*)(ws + WS_MEMN);
    float* ROT = (float*)(ws + WS_ROT);
#define WPTR(l, off) ((bf16_t*)(ws + WS_W + (size_t)(l) * LW_STRIDE + (off)))
#define KVM(l) ((bf16_t*)(ws + WS_KMEM + (size_t)(l) * 4 * MiB))
    bf16_t* VPT = (bf16_t*)(ws + WS_VP);
    bf16_t* WPP = (bf16_t*)(ws + WS_VP + 8 * MiB);

        constexpr int I_IN = 16 * 72, I_SQ = 16 * 32, I_KV = 16 * 64, I_UP = 16 * 128, I_DN = 64 * 32;
        constexpr int I_LAYER = I_IN + I_SQ + I_KV + I_SQ + I_UP + I_DN;
        auto decode = [&](int it) -> TItem {
            const int l = it / I_LAYER; int r = it % I_LAYER;
            if (r < I_IN) return TItem{w_in + (size_t)l * D * INC, WPTR(l, LW_IN), norm_mix_g + l * D, nullptr, D, INC, 1536, 2176, r}; r -= I_IN;
            if (r < I_SQ) return TItem{w_out + (size_t)l * D * D, WPTR(l, LW_OUT), gnorm_conv_g + l * 512, gnorm_attn_g + l * 512, D, D, 0, 0, r}; r -= I_SQ;
            if (r < I_KV) return TItem{wx_kv + (size_t)l * D * 2 * D, WPTR(l, LW_KV), norm_mem_g + l * D, nullptr, D, 2 * D, 0, 0, r}; r -= I_KV;
            if (r < I_SQ) return TItem{wx_o + (size_t)l * D * D, WPTR(l, LW_O), nullptr, nullptr, D, D, 0, 0, r}; r -= I_SQ;
            if (r < I_UP) return TItem{w_up + (size_t)l * D * FF, WPTR(l, LW_UP), norm_mlp_g + l * D, nullptr, D, FF, 0, 0, r}; r -= I_UP;
            return TItem{w_down + (size_t)l * FF * D, WPTR(l, LW_DN), nullptr, nullptr, FF, D, 0, 0, r};
        };
    constexpr int NIF = 4;
    constexpr int N_EARLY = I_LAYER + I_IN + I_KV + I_SQ, N_LATE = I_SQ + I_UP + I_DN;
    auto early_it = [&](int e) -> int { const int e1 = e - I_LAYER; return e < I_LAYER ? e : I_LAYER + (e1 < I_IN ? e1 : e1 + I_SQ); };
    auto late_it = [&](int j) -> int { return I_LAYER + I_IN + (j < I_SQ ? j : j + I_KV + I_SQ); };
    if (IN(0)) for (int rep = 0; rep < REP0; ++rep) {
        LAS float* tsc = (LAS float*)(lds + wid * 16384);
        {
            const int n_now = (G >= 256) ? N_EARLY : N_EARLY + N_LATE;
            for (int e = gw; e < n_now; e += NIF * NGW) {
                float v[NIF][32];
#pragma unroll
                for (int q = 0; q < NIF; ++q) { const int eq = e + q * NGW; if (eq < n_now) { const TItem t = decode(eq < N_EARLY ? early_it(eq) : late_it(eq - N_EARLY)); p0_item_load(t, v[q], lane); } }
#pragma unroll
                for (int q = 0; q < NIF; ++q) { const int eq = e + q * NGW; if (eq < n_now) { const TItem t = decode(eq < N_EARLY ? early_it(eq) : late_it(eq - N_EARLY)); p0_item_finish(t, v[q], tsc, lane); } }
            }
        }
        constexpr int NROWS = T + MROWS + DEPTH * D;
        for (int m0 = gw; m0 < NROWS; m0 += 2 * NGW) {
            f32x4 v[2][4];
#pragma unroll
            for (int q = 0; q < 2; ++q) {
                const int m = m0 + q * NGW;
                if (m < NROWS) {
                    const float* src = (m < T) ? x_in + (size_t)m * D : (m < T + MROWS) ? mem + (size_t)(m - T) * D : wx_q + (size_t)(m - T - MROWS) * D;
                    const f32x4* xr = (const f32x4*)src + lane;
#pragma unroll
                    for (int j = 0; j < 4; ++j) v[q][j] = __builtin_nontemporal_load(xr + 64 * j);
                }
            }
#pragma unroll
            for (int q = 0; q < 2; ++q) {
                const int m = m0 + q * NGW;
                if (m < NROWS) {
                    const bool isx = m < T, ismem = !isx && m < T + MROWS; const int row = isx ? m : ismem ? m - T : m - T - MROWS;
                    float rs = 1.0f;
                    if (isx || ismem) {
                        float s = 0.f;
#pragma unroll
                        for (int j = 0; j < 4; ++j) s += (v[q][j][0] * v[q][j][0] + v[q][j][1] * v[q][j][1]) + (v[q][j][2] * v[q][j][2] + v[q][j][3] * v[q][j][3]);
                        s = wave_sum(s);
                        if (ismem) rs = 1.0f / sqrtf(s * (1.0f / 1024.0f) + EPS);
                        else if (lane < 16) SSQ[(size_t)row * 16 + lane] = (lane == 0) ? s : 0.f;
                    } else rs = norm_x_g[row];
                    bf16_t* dst = isx ? XB + (size_t)row * D : ismem ? MEMN + (size_t)row * D : WPTR(row >> 10, LW_Q) + (size_t)(row & 1023) * D;
                    u32x2* o8 = (u32x2*)dst + lane;
#pragma unroll
                    for (int j = 0; j < 4; ++j) { u32x2 w; w.x = pk2(v[q][j][0] * rs, v[q][j][1] * rs); w.y = pk2(v[q][j][2] * rs, v[q][j][3] * rs); o8[64 * j] = w; }
                }
            }
        }
        for (int idx = (vcu * 512 + tid); idx < T * 32; idx += G * 512) {
            const int tok = idx >> 5, i = idx & 31;
            double f = 1.0; for (int k = 0; k < i; ++k) f *= 0.74989420933245582730;
            const float inv = (float)f;
            const float ang = (float)positions[tok] * inv;
            double rev = (double)ang * 0.15915494309189533577; rev -= __builtin_rint(rev);
            const float rv = (float)rev;
            f32x2 cs = {__builtin_amdgcn_cosf(rv), __builtin_amdgcn_sinf(rv)};
            *(f32x2*)(ROT + (size_t)idx * 2) = cs;
        }
    }
    SEAM(0);
    if (tid == 0) {
        unsigned fastv = 0u, xv = (unsigned)bx % 8u, offv = (unsigned)bx / 8u;
        if (hi - lo > 1 && G == 256) {
            unsigned npop = 0u, ok = 1u, below = 0u;
#pragma unroll
            for (unsigned j = 0; j < 16; ++j) { const unsigned c = xb_ld(&bar.bar[XB_XCNT(j)]); if (c) { ++npop; if (c != 32u) ok = 0u; if (j < bar.x) ++below; } }
            if (FORCE_FALLBACK == 0 && ok && npop == 8u && xb_ld(&bar.bar[XB_TMO]) == 0u) { fastv = 1u; xv = below; offv = MISC[12]; }
        }
        MISC[16] = fastv; MISC[17] = xv; MISC[18] = offv;
    }
    __syncthreads();
    const bool fast = MISC[16] != 0u;
    const int vx = (int)MISC[17], voff = (int)MISC[18];
    const int cc = (G % 8 == 0) ? voff * 8 + vx : bx;
    unsigned* tcnt = (unsigned*)args.ws + 4096 + (vx * 8 + (voff & 7)) * 64;
    unsigned tgen = 0u;
    unsigned* war3 = (unsigned*)args.ws + 8192; unsigned* war6 = (unsigned*)args.ws + 8192 + 64; unsigned* war8 = (unsigned*)args.ws + 8192 + 128; unsigned* war5 = (unsigned*)args.ws + 8192 + 192;

#pragma unroll 1
    for (int l = 0; l < DEPTH; ++l) {
        const int pb = 1 + 9 * l;
        if (IN(pb + 0)) for (int rep = 0; rep < REP1; ++rep) {
            { pg8::Gemm g = pg8::std_gemm(XB, WPTR(l, LW_IN), D, D, D, T / 256, INC / 256); pg8::StaticOrder S; S.init(T / 256, INC / 256, G, cc);
              pg8::EpiWin E{U, SSQ, ROT, fill_rstd_table(S, SSQ, scr), (fast && l > 0) ? war8 : nullptr, (unsigned)G * (unsigned)l, bar.bar}; pg8::gemm_phase(lds, scr, g, S, E); }
            if (l == 0) {
#pragma unroll 1
                for (int j = 0; j < 2; ++j) {
                    pg8::Gemm g = pg8::std_gemm(MEMN, WPTR(j, LW_KV), D, D, D, 4, 8); pg8::StaticOrder S; S.init(4, 8, G, (cc + 4 * G - 64 - 32 * j) % G);
                    pg8::EpiScale<0> E{KVM(j), 2 * D, nullptr, 1.0f}; pg8::gemm_phase(lds, scr, g, S, E);
                }
                if (G >= 256 && cc >= 128) {
                    int tid2 = threadIdx.x; asm volatile("" : "+v"(tid2));
                    const int lane2 = tid2 & 63, wid2 = __builtin_amdgcn_readfirstlane(tid2 >> 6);
                    LAS float* tsc2 = (LAS float*)(lds + wid2 * 16384);
                    const int lw = (cc - 128) * 8 + wid2, NLW = (G - 128) * 8;
#pragma unroll 1
                    for (int j0 = lw; j0 < N_LATE; j0 += NLW) {
                        float v[32];
                        const TItem t = decode(late_it(j0));
                        p0_item_load(t, v, lane2);
                        p0_item_finish(t, v, tsc2, lane2);
                    }
                    __syncthreads();
                }
            } else {
                if (fast) guard_wait(war6, (unsigned)G * (unsigned)l, bar.bar);
                { pg8::Gemm g{WPTR(l, LW_O), KVM(l) + D, 256, D, 2 * D, 16, 4, 4, 0, 256L * D, 256, 4, 256L * 2 * D, 0, 256}; pg8::StaticOrder S; S.init(16, 4, G, (cc + 4 * G - 64) % G);
                  pg8::EpiScale<0> E{VPT, D, nullptr, 1.0f}; pg8::gemm_phase(lds, scr, g, S, E); }
                if (fast) guard_wait(war5, (unsigned)G * (unsigned)l, bar.bar);
                { pg8::Gemm g{KVM(l), WPTR(l, LW_Q), 256, 2 * D, D, 16, 4, 4, 256L * 2 * D, 256, 0, 4, 0, 256, 256L * D}; pg8::StaticOrder S; S.init(16, 4, G, (cc + 4 * G - 128) % G);
                  pg8::EpiScale<0> E{WPP, D, nullptr, 1.0f}; pg8::gemm_phase(lds, scr, g, S, E); }
            }
        }
        SEAM(pb + 0);
        if (IN(pb + 1)) for (int rep = 0; rep < REP2; ++rep) {
            const int unit0 = fast ? ((8 * vx + (voff & 7)) * 4 + (voff >> 3)) : vcu;
            for (int unit = unit0; unit < NB * 64; unit += G) {
                if ((unit & 63) >= 2) swa_conv_unit<false>(unit, U, MIX, conv_w + l * 3 * 512, sinks + l * 8, lds);
                else swa_conv_unit<true>(unit, U, MIX, conv_w + l * 3 * 512, sinks + l * 8, lds);
            }
        }
        if (l == 0 && IN(pb + 1)) {
            { pg8::Gemm g{WPTR(0, LW_O), KVM(0) + D, 256, D, 2 * D, 16, 4, 4, 0, 256L * D, 256, 4, 256L * 2 * D, 0, 256}; pg8::StaticOrder S; S.init(16, 4, G, cc);
              pg8::EpiScale<0> E{VPT, D, nullptr, 1.0f}; pg8::gemm_phase(lds, scr, g, S, E); }
            { pg8::Gemm g{KVM(0), WPTR(0, LW_Q), 256, 2 * D, D, 16, 4, 4, 256L * 2 * D, 256, 0, 4, 0, 256, 256L * D}; pg8::StaticOrder S; S.init(16, 4, G, (cc + 4 * G - 64) % G);
              pg8::EpiScale<0> E{WPP, D, nullptr, 1.0f}; pg8::gemm_phase(lds, scr, g, S, E); }
        }
        if (l == 0) SEAM(pb + 1); else TSEAM(pb + 1);
        if (IN(pb + 2)) {
            pg8::Gemm g = pg8::std_gemm(MIX, WPTR(l, LW_OUT), D, D, D, T / 256, 4); pg8::StaticOrder S; S.init(T / 256, 4, G, cc);
            if (l == 0) { pg8::EpiResid<0> E{x_in, out, XB, SSQ}; pg8::gemm_phase(lds, scr, g, S, E); } else { pg8::EpiResid<1> E{x_in, out, XB, SSQ}; pg8::gemm_phase(lds, scr, g, S, E); }
        }
        TSEAM(pb + 2);
        if (fast && tid == 0) (void)xb_add(war3, 1u);
        if (IN(pb + 3)) for (int rep = 0; rep < REP4; ++rep) {
            pg8::Gemm g{XB, WPP, D, D, D, T / 256, 4, 1, 256L * D, 0, 0, 16, (long)D * D, 0, 256L * D}; pg8::StaticOrder S; S.init(T / 256, 4, G, cc);
            pg8::EpiSoftmax E{PB, D, SSQ, XSCALE, fill_rstd_table(S, SSQ, scr)}; pg8::gemm_phase(lds, scr, g, S, E);
        }
        if (fast && tid == 0) (void)xb_add(war5, 1u);
        TSEAM(pb + 4);
        if (IN(pb + 6)) {
            pg8::Gemm g{PB, VPT, D, D, D, T / 256, 4, 1, 256L * D, 0, 0, 16, (long)D * D, 0, 256L * D}; pg8::StaticOrder S; S.init(T / 256, 4, G, cc);
            pg8::EpiResid<1> E{x_in, out, XB, SSQ}; pg8::gemm_phase(lds, scr, g, S, E);
        }
        if (fast) { if (IN(pb + 6) && IN(pb + 7)) { team_barrier(tcnt, bar.bar, tgen); if (tid == 0) (void)xb_add(war6, 1u); guard_wait(war3, (unsigned)G * (unsigned)(l + 1), bar.bar); } }
        else SEAM(pb + 6);
        if (IN(pb + 7)) for (int rep = 0; rep < REP7; ++rep) {
            pg8::Gemm g = pg8::std_gemm(XB, WPTR(l, LW_UP), D, D, D, T / 256, FF / 256); pg8::StaticOrder S; S.init(T / 256, FF / 256, G, cc);
            pg8::EpiScale<1> E{HB, FF, SSQ, 1.0f, fill_rstd_table(S, SSQ, scr)}; pg8::gemm_phase(lds, scr, g, S, E);
        }
        TSEAM(pb + 7);
        if (IN(pb + 8)) {
            pg8::Gemm g = pg8::std_gemm(HB, WPTR(l, LW_DN), FF, FF, FF, T / 256, 4); pg8::StaticOrder S; S.init(T / 256, 4, G, cc);
            if (l == DEPTH - 1) {
                if (fast) guard_wait(war6, (unsigned)G * (unsigned)DEPTH, bar.bar);
                if (fast) { pg8::EpiFinal E{out, XB, SSQ, final_g, tcnt, bar.bar, tgen}; pg8::gemm_phase(lds, scr, g, S, E); ++tgen; }
                else { pg8::EpiResid<2> E{x_in, out, XB, SSQ}; pg8::gemm_phase(lds, scr, g, S, E); }
            } else { pg8::EpiResid<1> E{x_in, out, XB, SSQ}; pg8::gemm_phase(lds, scr, g, S, E); }
        }
        if (fast) {
            if (l < DEPTH - 1 && IN(pb + 8) && IN(pb + 9)) { if (tid == 0) (void)xb_add(war8, 1u); team_barrier(tcnt, bar.bar, tgen); }
        } else SEAM(pb + 8);
    }
    if (IN(19) && !fast) {
        for (int m = gw; m < T; m += NGW) {
            const float rs = row_rstd(SSQ, m);
            f32x4* xr = (f32x4*)(out + (size_t)m * D) + lane; const f32x4* gr = (const f32x4*)final_g + lane;
#pragma unroll
            for (int j = 0; j < 4; ++j) { const f32x4 v = xr[64 * j], gv = gr[64 * j]; xr[64 * j] = v * rs * gv; }
        }
    }
#undef IN
#undef SEAM
#undef TSEAM
}

extern "C" void kernel_launch(void* const* d_in, const int* in_sizes, int n_in, void* d_out, int out_size, void* d_ws, size_t ws_size, hipStream_t stream) {
    static int grid = 0;
    if (grid == 0) {
        if (n_in != 19 || in_sizes[0] != T * D || out_size != T * D || ws_size < WS_END) { fprintf(stderr, "kernel_launch: unexpected shapes (n_in %d, in0 %d, out %d, ws %zu)\n", n_in, n_in > 0 ? in_sizes[0] : -1, out_size, ws_size); grid = -1; return; }
        int dev = 0, cus = 0, per_cu = 0;
        if (hipGetDevice(&dev) != hipSuccess || hipDeviceGetAttribute(&cus, hipDeviceAttributeMultiprocessorCount, dev) != hipSuccess) { grid = -1; return; }
        if (hipFuncSetAttribute((const void*)mk_fwd, hipFuncAttributeMaxDynamicSharedMemorySize, LDS_BYTES) != hipSuccess) { fprintf(stderr, "kernel_launch: hipFuncSetAttribute failed\n"); grid = -1; return; }
        if (hipOccupancyMaxActiveBlocksPerMultiprocessor(&per_cu, (const void*)mk_fwd, 512, LDS_BYTES) != hipSuccess || per_cu < 1) { fprintf(stderr, "kernel_launch: occupancy query failed (%d)\n", per_cu); (void)hipGetLastError(); grid = -1; return; }
        grid = cus * per_cu;
    }
    if (grid < 0) return;
    Args a{};
    for (int i = 0; i < 19; ++i) a.in[i] = d_in[i];
    a.out = (float*)d_out; a.ws = (unsigned char*)d_ws;
    if (hipMemsetAsync(d_ws, 0, 65536, stream) != hipSuccess) { fprintf(stderr, "kernel_launch: memset of barrier words failed\n"); return; }
#if MK_MULTI
    for (int p = 0; p < N_PHASES; ++p) {
        a.ph_lo = p; a.ph_hi = p + 1;
        hipLaunchKernelGGL(mk_fwd, dim3(grid), dim3(512), LDS_BYTES, stream, a);
    }
#else
    a.ph_lo = 0; a.ph_hi = N_PHASES;
    void* kargs[] = {&a};
    hipError_t e = hipLaunchCooperativeKernel((const void*)mk_fwd, dim3(grid), dim3(512), kargs, LDS_BYTES, stream);
    if (e != hipSuccess) fprintf(stderr, "cooperative launch failed: %s (grid %d)\n", hipGetErrorString(e), grid);
#endif
}
```
